# Optimizing an MI355X kernel written in HIP

```python
import math
import jax, jax.numpy as jnp
from jax import lax
import numpy as np

D_MODEL = 1024
BATCH = 8
SEQ = 2048
DEPTH = 1
DEC_BATCH = 16
DEC_SEQ = 64
PAST_LEN = 2048

CHUNK = 64
Q_BLOCK = 128
HG_KEY_DIM = 128
N_HG_HEADS = D_MODEL // HG_KEY_DIM
HG_VAL_DIM = D_MODEL // N_HG_HEADS
DA_HEAD_DIM = 64
N_DA_HEADS = D_MODEL // (2 * DA_HEAD_DIM)
DA_V_DIM = 2 * DA_HEAD_DIM
D_FF = 128 * ((8 * D_MODEL // 3 + 127) // 128)
CONV_WIDTH = 3
LN_EPS = 1e-5
DEEPNORM_ALPHA = (2 * DEPTH) ** 0.25
DEEPNORM_BETA = (8 * DEPTH) ** -0.25
DA_SCALE = DA_HEAD_DIM ** -0.5

HG_QK = N_HG_HEADS * HG_KEY_DIM
HG_V = N_HG_HEADS * HG_VAL_DIM
DA_QK = N_DA_HEADS * 2 * DA_HEAD_DIM
DA_V = N_DA_HEADS * DA_V_DIM
IN_SPLITS = (HG_QK, HG_QK, HG_V, HG_V, DA_QK, DA_QK, DA_V, D_MODEL, D_MODEL)
IN_WIDTH = sum(IN_SPLITS)

kernel_name = "hgrn2_diffattn_streaming_encoder_step"


def _layer_norm(x, g, b):
    xf = x.astype(jnp.float32)
    mu = jnp.mean(xf, axis=-1, keepdims=True)
    var = jnp.mean(jnp.square(xf - mu), axis=-1, keepdims=True)
    return ((xf - mu) * lax.rsqrt(var + LN_EPS) * g + b).astype(x.dtype)


def _rms_norm(x, g):
    xf = x.astype(jnp.float32)
    return (xf * lax.rsqrt(jnp.mean(jnp.square(xf), axis=-1, keepdims=True) + LN_EPS) * g).astype(x.dtype)


def _split_in(u):
    outs, off = [], 0
    for w in IN_SPLITS:
        outs.append(u[..., off:off + w])
        off += w
    return outs


def _hgrn2(q, k, v, logf, s0):
    B, T, H, K = q.shape
    V = v.shape[-1]
    C = min(CHUNK, T)
    n = T // C

    def to_chunks(a):
        return a.reshape(B, n, C, H, a.shape[-1]).transpose(1, 0, 3, 2, 4)

    causal = jnp.tril(jnp.ones((C, C), dtype=bool))[:, :, None]

    def step(S, inp):
        qc, kc, vc, gc = inp
        b = jnp.cumsum(gc, axis=2)
        diff = b[:, :, :, None, :] - b[:, :, None, :, :]
        dec = jnp.exp(jnp.where(causal, diff, -jnp.inf))
        att = jnp.einsum('bhtk,bhtsk,bhsk->bhts', qc, dec, kc)
        o = jnp.einsum('bhts,bhsv->bhtv', att, vc) + jnp.einsum('bhtk,bhkv->bhtv', qc * jnp.exp(b), S)
        b_last = b[:, :, -1]
        S_new = jnp.exp(b_last)[..., None] * S + jnp.einsum(
            'bhsk,bhsv->bhkv', kc * jnp.exp(b_last[:, :, None, :] - b), vc)
        return S_new, o

    S, o = lax.scan(step, s0, (to_chunks(q), to_chunks(k), to_chunks(v), to_chunks(logf)))
    o = o.transpose(1, 0, 3, 2, 4).reshape(B, T, H, V)
    return S, o


def _diff_attend(q, k, v, lam, mask):
    s = jnp.einsum('bqhcd,bshcd->bhcqs', q.astype(jnp.float32), k.astype(jnp.float32)) * DA_SCALE
    s = jnp.where(mask, s, -jnp.inf)
    p = jax.nn.softmax(s, axis=-1)
    w = p[:, :, 0] - lam * p[:, :, 1]
    return jnp.einsum('bhqs,bshe->bqhe', w.astype(v.dtype), v)


def _diff_attn_prompt(q, k, v, lam):
    B, T = q.shape[:2]
    nb = T // Q_BLOCK
    qb = q.reshape(B, nb, Q_BLOCK, N_DA_HEADS, 2, DA_HEAD_DIM).transpose(1, 0, 2, 3, 4, 5)
    k_chunk = jnp.arange(T) // CHUNK

    def block(args):
        qi, i = args
        q_chunk = (i * Q_BLOCK + jnp.arange(Q_BLOCK)) // CHUNK
        mask = k_chunk[None, :] <= q_chunk[:, None]
        return _diff_attend(qi, k, v, lam, mask)

    o = lax.map(block, (qb, jnp.arange(nb)))
    return o.transpose(1, 0, 2, 3, 4).reshape(B, T, N_DA_HEADS, DA_V_DIM)


def _layer(x, l, lb, hg_s0, past_k, past_v, ffn_buf0, w_in, hg_norm_g, lq1, lk1, lq2, lk2,
           subln_g, w_br_hg, w_br_da, w_out, ln1_g, ln1_b, w_up, conv_w, conv_b, w_down,
           ln2_g, ln2_b):
    B, T, _ = x.shape
    hq, hf, hi, hog, dq, dk, dv, g_hg, g_da = _split_in(x @ w_in)

    lb_hk = lb.reshape(N_HG_HEADS, HG_KEY_DIM)
    q = hq.reshape(B, T, N_HG_HEADS, HG_KEY_DIM).astype(jnp.float32)
    f = lb_hk + (1.0 - lb_hk) * jax.nn.sigmoid(hf.reshape(B, T, N_HG_HEADS, HG_KEY_DIM).astype(jnp.float32))
    logf = jnp.log(f)
    kk = 1.0 - f
    vv = hi.reshape(B, T, N_HG_HEADS, HG_VAL_DIM).astype(jnp.float32)
    s_new, o = _hgrn2(q, kk, vv, logf, hg_s0.astype(jnp.float32))
    o = _rms_norm(o, hg_norm_g.astype(jnp.float32)) * jax.nn.sigmoid(
        hog.reshape(B, T, N_HG_HEADS, HG_VAL_DIM).astype(jnp.float32))
    y_hg = o.reshape(B, T, HG_V).astype(x.dtype)

    lam_init = 0.8 - 0.6 * math.exp(-0.3 * l)
    lam = (jnp.exp(jnp.sum(lq1.astype(jnp.float32) * lk1.astype(jnp.float32)))
           - jnp.exp(jnp.sum(lq2.astype(jnp.float32) * lk2.astype(jnp.float32))) + lam_init)
    q5 = dq.reshape(B, T, N_DA_HEADS, 2, DA_HEAD_DIM)
    k5 = dk.reshape(B, T, N_DA_HEADS, 2, DA_HEAD_DIM)
    v4 = dv.reshape(B, T, N_DA_HEADS, DA_V_DIM)
    if past_k is None:
        a = _diff_attn_prompt(q5, k5, v4, lam)
    else:
        P = past_k.shape[1]
        k_all = jnp.concatenate([past_k.reshape(B, P, N_DA_HEADS, 2, DA_HEAD_DIM).astype(k5.dtype), k5], axis=1)
        v_all = jnp.concatenate([past_v.astype(v4.dtype), v4], axis=1)
        mask = jnp.ones((T, P + T), dtype=bool)
        a = _diff_attend(q5, k_all, v_all, lam, mask)
    a = _rms_norm(a, subln_g) * (1.0 - lam_init)
    y_da = a.reshape(B, T, DA_V)

    m = jax.nn.sigmoid(g_hg) * (y_hg @ w_br_hg) + jax.nn.sigmoid(g_da) * (y_da @ w_br_da)
    h = _layer_norm(DEEPNORM_ALPHA * x + m @ w_out, ln1_g, ln1_b)

    up = h @ w_up
    buf = jnp.concatenate([ffn_buf0.astype(up.dtype), up], axis=1)
    c = conv_b
    for j in range(CONV_WIDTH):
        c = c + conv_w[j] * buf[:, j:j + T]
    val, gate = jnp.split(c, 2, axis=-1)
    ffn = (jax.nn.silu(gate) * val) @ w_down
    out = _layer_norm(DEEPNORM_ALPHA * h + ffn, ln2_g, ln2_b)

    new_k = k5.reshape(B, T, N_DA_HEADS, 2 * DA_HEAD_DIM)
    return out, new_k, v4, s_new.astype(x.dtype), buf[:, -(CONV_WIDTH - 1):]


def setup_inputs(seed: int = 0) -> dict:
    key = jax.random.key(seed)
    ks = jax.random.split(key, 26)

    def nrm(k, shape, scale):
        return jax.random.normal(k, shape, jnp.float32) * scale

    off_hi = 2 * HG_QK
    off_dv = 2 * HG_QK + 2 * HG_V + 2 * DA_QK
    col_scale = jnp.concatenate([
        jnp.ones((off_hi,), jnp.float32), jnp.full((HG_V,), DEEPNORM_BETA, jnp.float32),
        jnp.ones((HG_V + 2 * DA_QK,), jnp.float32), jnp.full((DA_V,), DEEPNORM_BETA, jnp.float32),
        jnp.ones((2 * D_MODEL,), jnp.float32)])
    assert off_dv == off_hi + 2 * HG_V + 2 * DA_QK - HG_V + HG_V
    return {
        "x_prompt": nrm(ks[0], (BATCH, SEQ, D_MODEL), 1.0),
        "x_sample": nrm(ks[1], (DEC_BATCH, DEC_SEQ, D_MODEL), 1.0),
        "cache_k": nrm(ks[2], (DEPTH, DEC_BATCH, PAST_LEN, N_DA_HEADS, 2 * DA_HEAD_DIM), 1.0),
        "cache_v": nrm(ks[3], (DEPTH, DEC_BATCH, PAST_LEN, N_DA_HEADS, DA_V_DIM), DEEPNORM_BETA),
        "state_hgrn": nrm(ks[4], (DEPTH, DEC_BATCH, N_HG_HEADS, HG_KEY_DIM, HG_VAL_DIM), 0.5),
        "state_ffn_conv": nrm(ks[5], (DEPTH, DEC_BATCH, CONV_WIDTH - 1, 2 * D_FF), 0.5),
        "w_in": nrm(ks[6], (DEPTH, D_MODEL, IN_WIDTH), D_MODEL ** -0.5) * col_scale,
        "hg_lb_logits": nrm(ks[7], (DEPTH + 1, HG_QK), 0.5),
        "hg_norm_g": 1.0 + nrm(ks[8], (DEPTH, HG_VAL_DIM), 0.02),
        "da_lambda_q1": nrm(ks[9], (DEPTH, DA_HEAD_DIM), 0.1),
        "da_lambda_k1": nrm(ks[10], (DEPTH, DA_HEAD_DIM), 0.1),
        "da_lambda_q2": nrm(ks[11], (DEPTH, DA_HEAD_DIM), 0.1),
        "da_lambda_k2": nrm(ks[12], (DEPTH, DA_HEAD_DIM), 0.1),
        "da_subln_g": 1.0 + nrm(ks[13], (DEPTH, DA_V_DIM), 0.02),
        "w_br_hg": nrm(ks[14], (DEPTH, HG_V, D_MODEL), HG_V ** -0.5 * DEEPNORM_BETA),
        "w_br_da": nrm(ks[15], (DEPTH, DA_V, D_MODEL), DA_V ** -0.5 * DEEPNORM_BETA),
        "w_out": nrm(ks[16], (DEPTH, D_MODEL, D_MODEL), D_MODEL ** -0.5 * DEEPNORM_BETA),
        "ln1_g": 1.0 + nrm(ks[17], (DEPTH, D_MODEL), 0.02),
        "ln1_b": nrm(ks[18], (DEPTH, D_MODEL), 0.02),
        "w_up": nrm(ks[19], (DEPTH, D_MODEL, 2 * D_FF), D_MODEL ** -0.5 * DEEPNORM_BETA),
        "conv_w": nrm(ks[20], (DEPTH, CONV_WIDTH, 2 * D_FF), CONV_WIDTH ** -0.5),
        "conv_b": nrm(ks[21], (DEPTH, 2 * D_FF), 0.02),
        "w_down": nrm(ks[22], (DEPTH, D_FF, D_MODEL), D_FF ** -0.5 * DEEPNORM_BETA),
        "ln2_g": 1.0 + nrm(ks[23], (DEPTH, D_MODEL), 0.02),
        "ln2_b": nrm(ks[24], (DEPTH, D_MODEL), 0.02),
    }


def reference(x_prompt, x_sample, cache_k, cache_v, state_hgrn, state_ffn_conv, w_in, hg_lb_logits,
              hg_norm_g, da_lambda_q1, da_lambda_k1, da_lambda_q2, da_lambda_k2, da_subln_g,
              w_br_hg, w_br_da, w_out, ln1_g, ln1_b, w_up, conv_w, conv_b, w_down, ln2_g, ln2_b):
    lb_all = jnp.cumsum(jax.nn.softmax(hg_lb_logits.astype(jnp.float32), axis=0), axis=0)[:DEPTH]
    xp, xs = x_prompt, x_sample
    kp, vp, sp, cp, kd, vd, sd, cd = [], [], [], [], [], [], [], []
    for l in range(DEPTH):
        w = (w_in[l], hg_norm_g[l], da_lambda_q1[l], da_lambda_k1[l], da_lambda_q2[l], da_lambda_k2[l],
             da_subln_g[l], w_br_hg[l], w_br_da[l], w_out[l], ln1_g[l], ln1_b[l], w_up[l], conv_w[l],
             conv_b[l], w_down[l], ln2_g[l], ln2_b[l])
        hg0 = jnp.zeros((xp.shape[0], N_HG_HEADS, HG_KEY_DIM, HG_VAL_DIM), jnp.float32)
        buf0 = jnp.zeros((xp.shape[0], CONV_WIDTH - 1, 2 * D_FF), xp.dtype)
        xp, k1, v1, s1, c1 = _layer(xp, l, lb_all[l], hg0, None, None, buf0, *w)
        xs, k2, v2, s2, c2 = _layer(xs, l, lb_all[l], state_hgrn[l], cache_k[l], cache_v[l],
                                    state_ffn_conv[l], *w)
        kp.append(k1); vp.append(v1); sp.append(s1); cp.append(c1)
        kd.append(k2); vd.append(v2); sd.append(s2); cd.append(c2)
    k_prompt = jnp.stack(kp); v_prompt = jnp.stack(vp)
    hgrn_prompt = jnp.stack(sp); conv_prompt = jnp.stack(cp)
    k_sample = jnp.stack(kd); v_sample = jnp.stack(vd)
    hgrn_sample = jnp.stack(sd); conv_sample = jnp.stack(cd)
    return (xp, xs, k_prompt, v_prompt, hgrn_prompt, conv_prompt, k_sample, v_sample, hgrn_sample, conv_sample)
```

```cpp
#include <hip/hip_runtime.h>
#include <cstdio>
#include <cstdint>
namespace slow {
constexpr int DM = 1024, NH = 8, HD = 128, DFF = 2816, INW = 9216;
constexpr float ALPHA = 1.189207115002721f;
constexpr float LN_EPS = 1e-5f;
constexpr float LAM_INIT = 0.2f;

__global__ void __launch_bounds__(256) sgemm(const float* __restrict__ A, int lda, const float* __restrict__ B, int ldb, float* __restrict__ C, int ldc, int K) {
    __shared__ float As[8][128 + 4];
    __shared__ float Bs[8][128 + 4];
    const int tid = threadIdx.x, tx = tid & 15, ty = tid >> 4;
    const int m0 = blockIdx.y * 128, n0 = blockIdx.x * 128;
    float acc[8][8];
#pragma unroll
    for (int i = 0; i < 8; ++i)
#pragma unroll
        for (int j = 0; j < 8; ++j) acc[i][j] = 0.f;
    for (int k0 = 0; k0 < K; k0 += 8) {
        { const int r = tid >> 1, c = (tid & 1) * 4; const float4 v = *(const float4*)(A + (size_t)(m0 + r) * lda + k0 + c);
          As[c + 0][r] = v.x; As[c + 1][r] = v.y; As[c + 2][r] = v.z; As[c + 3][r] = v.w; }
        { const int r = tid >> 5, c = (tid & 31) * 4; const float4 v = *(const float4*)(B + (size_t)(k0 + r) * ldb + n0 + c);
          *(float4*)&Bs[r][c] = v; }
        __syncthreads();
#pragma unroll
        for (int kk = 0; kk < 8; ++kk) {
            float a[8], b[8];
#pragma unroll
            for (int i = 0; i < 8; ++i) a[i] = As[kk][ty * 8 + i];
#pragma unroll
            for (int j = 0; j < 8; ++j) b[j] = Bs[kk][tx * 8 + j];
#pragma unroll
            for (int i = 0; i < 8; ++i)
#pragma unroll
                for (int j = 0; j < 8; ++j) acc[i][j] = fmaf(a[i], b[j], acc[i][j]);
        }
        __syncthreads();
    }
#pragma unroll
    for (int i = 0; i < 8; ++i) {
        float* cp = C + (size_t)(m0 + ty * 8 + i) * ldc + n0 + tx * 8;
        *(float4*)cp = make_float4(acc[i][0], acc[i][1], acc[i][2], acc[i][3]);
        *(float4*)(cp + 4) = make_float4(acc[i][4], acc[i][5], acc[i][6], acc[i][7]);
    }
}

__global__ void params_k(const float* logits, const float* lq1, const float* lk1, const float* lq2, const float* lk2, float* P) {
    const int t = threadIdx.x + blockIdx.x * blockDim.x;
    if (t < 1024) { const float a = logits[t], b = logits[1024 + t]; const float m = fmaxf(a, b); const float ea = expf(a - m), eb = expf(b - m); P[t] = ea / (ea + eb); }
    if (t == 0) { float s1 = 0.f, s2 = 0.f; for (int i = 0; i < 64; ++i) { s1 += lq1[i] * lk1[i]; s2 += lq2[i] * lk2[i]; } P[1024] = expf(s1) - expf(s2) + LAM_INIT; }
}

__global__ void __launch_bounds__(256) hgrn_k(const float* __restrict__ hq, const float* __restrict__ hf, const float* __restrict__ hi, const float* __restrict__ lb,
                                              const float* __restrict__ s0, float* __restrict__ O, float* __restrict__ Sout, int T) {
    __shared__ float fs[128], ks[128], qs[128], part[128];
    const int seq = blockIdx.x >> 3, h = blockIdx.x & 7, tid = threadIdx.x, v = tid & 127, kh = tid >> 7;
    float S[64];
#pragma unroll
    for (int i = 0; i < 64; ++i) S[i] = s0 ? s0[(((size_t)seq * 8 + h) * 128 + kh * 64 + i) * 128 + v] : 0.f;
    for (int t = 0; t < T; ++t) {
        const size_t row = (size_t)seq * T + t;
        if (tid < 128) { const float x = hf[row * 1024 + h * 128 + tid]; const float l = lb[h * 128 + tid]; const float f = l + (1.f - l) / (1.f + expf(-x)); fs[tid] = f; ks[tid] = 1.f - f; qs[tid] = hq[row * 1024 + h * 128 + tid]; }
        __syncthreads();
        const float vv = hi[row * 1024 + h * 128 + v];
        float o = 0.f;
#pragma unroll
        for (int i = 0; i < 64; ++i) { const int k = kh * 64 + i; S[i] = fs[k] * S[i] + ks[k] * vv; o = fmaf(S[i], qs[k], o); }
        if (kh == 1) part[v] = o;
        __syncthreads();
        if (kh == 0) O[row * 1024 + h * 128 + v] = o + part[v];
    }
#pragma unroll
    for (int i = 0; i < 64; ++i) Sout[(((size_t)seq * 8 + h) * 128 + kh * 64 + i) * 128 + v] = S[i];
}

__global__ void __launch_bounds__(256) rms_gate_k(const float* __restrict__ O, const float* __restrict__ g, const float* __restrict__ gate, float cst, float* __restrict__ Y, int rows) {
    const int w = (blockIdx.x * 256 + threadIdx.x) >> 6, lane = threadIdx.x & 63;
    if (w >= rows * 8) return;
    const size_t base = (size_t)(w >> 3) * 1024 + (w & 7) * 128;
    const float a = O[base + lane], b = O[base + 64 + lane];
    float s = a * a + b * b;
    for (int o = 1; o < 64; o <<= 1) s += __shfl_xor(s, o);
    const float r = rsqrtf(s * (1.f / 128.f) + LN_EPS);
    float m0 = cst, m1 = cst;
    if (gate) { m0 = 1.f / (1.f + expf(-gate[base + lane])); m1 = 1.f / (1.f + expf(-gate[base + 64 + lane])); }
    Y[base + lane] = a * r * g[lane] * m0; Y[base + 64 + lane] = b * r * g[64 + lane] * m1;
}

__global__ void __launch_bounds__(256) attn_k(const float* __restrict__ Q, const float* __restrict__ Kn, const float* __restrict__ Vn, const float* __restrict__ Kp, const float* __restrict__ Vp,
                                              const float* __restrict__ Prm, float* __restrict__ A, int T, int P, int rows) {
    extern __shared__ float sm[];
    const int wl = threadIdx.x >> 6, lane = threadIdx.x & 63;
    const int w = blockIdx.x * 4 + wl;
    if (w >= rows * 8) return;
    const int h = w & 7, row = w >> 3, seq = row / T, t = row % T;
    const int L = P + T;
    float* s1 = sm + (size_t)wl * 2 * L; float* s2 = s1 + L;
    const int nk = P ? L : 64 * (t / 64 + 1);
    const float* q = Q + (size_t)row * 1024 + h * 128;
    float m1 = -1e30f, m2 = -1e30f;
    for (int s = lane; s < nk; s += 64) {
        const float* kr = (s < P) ? Kp + ((size_t)seq * P + s) * 1024 + h * 128 : Kn + ((size_t)seq * T + (s - P)) * 1024 + h * 128;
        float d1 = 0.f, d2 = 0.f;
        for (int d = 0; d < 64; ++d) { d1 = fmaf(q[d], kr[d], d1); d2 = fmaf(q[64 + d], kr[64 + d], d2); }
        d1 *= 0.125f; d2 *= 0.125f; s1[s] = d1; s2[s] = d2; m1 = fmaxf(m1, d1); m2 = fmaxf(m2, d2);
    }
    for (int o = 1; o < 64; o <<= 1) { m1 = fmaxf(m1, __shfl_xor(m1, o)); m2 = fmaxf(m2, __shfl_xor(m2, o)); }
    float l1 = 0.f, l2 = 0.f;
    for (int s = lane; s < nk; s += 64) { const float e1 = expf(s1[s] - m1), e2 = expf(s2[s] - m2); s1[s] = e1; s2[s] = e2; l1 += e1; l2 += e2; }
    for (int o = 1; o < 64; o <<= 1) { l1 += __shfl_xor(l1, o); l2 += __shfl_xor(l2, o); }
    const float lam = Prm[1024];
    const float i1 = 1.f / l1, i2 = lam / l2;
    for (int s = lane; s < nk; s += 64) s1[s] = s1[s] * i1 - s2[s] * i2;
    __builtin_amdgcn_s_waitcnt(0); __builtin_amdgcn_wave_barrier();
    float a0 = 0.f, a1 = 0.f;
    for (int s = 0; s < nk; ++s) {
        const float* vr = (s < P) ? Vp + ((size_t)seq * P + s) * 1024 + h * 128 : Vn + ((size_t)seq * T + (s - P)) * 1024 + h * 128;
        const float wv = s1[s];
        a0 = fmaf(wv, vr[lane], a0); a1 = fmaf(wv, vr[64 + lane], a1);
    }
    A[(size_t)row * 1024 + h * 128 + lane] = a0; A[(size_t)row * 1024 + h * 128 + 64 + lane] = a1;
}

__global__ void merge_k(const float* G1, const float* T1, const float* G2, const float* T2, float* Mo, size_t n) {
    for (size_t i = (size_t)blockIdx.x * blockDim.x + threadIdx.x; i < n; i += (size_t)gridDim.x * blockDim.x)
        Mo[i] = T1[i] / (1.f + expf(-G1[i])) + T2[i] / (1.f + expf(-G2[i]));
}
__global__ void __launch_bounds__(256) ln_k(const float* __restrict__ X, const float* __restrict__ R, const float* __restrict__ g, const float* __restrict__ b, float* __restrict__ Y, int rows) {
    const int w = (blockIdx.x * 256 + threadIdx.x) >> 6, lane = threadIdx.x & 63;
    if (w >= rows) return;
    float v[16]; float s = 0.f;
    for (int i = 0; i < 16; ++i) { const size_t o = (size_t)w * 1024 + i * 64 + lane; v[i] = ALPHA * X[o] + R[o]; s += v[i]; }
    for (int o = 1; o < 64; o <<= 1) s += __shfl_xor(s, o);
    const float mu = s * (1.f / 1024.f); float q = 0.f;
    for (int i = 0; i < 16; ++i) { v[i] -= mu; q += v[i] * v[i]; }
    for (int o = 1; o < 64; o <<= 1) q += __shfl_xor(q, o);
    const float r = rsqrtf(q * (1.f / 1024.f) + LN_EPS);
    for (int i = 0; i < 16; ++i) { const int c = i * 64 + lane; Y[(size_t)w * 1024 + c] = v[i] * r * g[c] + b[c]; }
}
__global__ void convgate_k(const float* __restrict__ UV, const float* __restrict__ UG, const float* __restrict__ buf0, const float* __restrict__ cw, const float* __restrict__ cb,
                           float* __restrict__ ACT, float* __restrict__ CS, int T, int W, int c0, int rows) {
    const size_t n = (size_t)rows * W;
    for (size_t i = (size_t)blockIdx.x * blockDim.x + threadIdx.x; i < n; i += (size_t)gridDim.x * blockDim.x) {
        const int row = (int)(i / W), c = (int)(i % W), seq = row / T, t = row % T;
        const int cv = c0 + c, cg_ = 2816 + c0 + c;
        float v2 = UV[(size_t)row * W + c], g2 = UG[(size_t)row * W + c];
        float v1, g1, v0, g0;
        if (t >= 1) { v1 = UV[(size_t)(row - 1) * W + c]; g1 = UG[(size_t)(row - 1) * W + c]; } else if (buf0) { v1 = buf0[((size_t)seq * 2 + 1) * 5632 + cv]; g1 = buf0[((size_t)seq * 2 + 1) * 5632 + cg_]; } else { v1 = 0.f; g1 = 0.f; }
        if (t >= 2) { v0 = UV[(size_t)(row - 2) * W + c]; g0 = UG[(size_t)(row - 2) * W + c]; } else if (buf0) { v0 = buf0[((size_t)seq * 2 + t) * 5632 + cv]; g0 = buf0[((size_t)seq * 2 + t) * 5632 + cg_]; } else { v0 = 0.f; g0 = 0.f; }
        const float val = cb[cv] + cw[cv] * v0 + cw[5632 + cv] * v1 + cw[2 * 5632 + cv] * v2;
        const float gat = cb[cg_] + cw[cg_] * g0 + cw[5632 + cg_] * g1 + cw[2 * 5632 + cg_] * g2;
        ACT[(size_t)row * 2816 + cv] = gat / (1.f + expf(-gat)) * val;
        if (t >= T - 2) { CS[((size_t)seq * 2 + (t - (T - 2))) * 5632 + cv] = v2; CS[((size_t)seq * 2 + (t - (T - 2))) * 5632 + cg_] = g2; }
    }
}

struct Ptrs { const float* in[25]; float* out; unsigned char* ws; };

static void run_group(const Ptrs& p, hipStream_t st, int nseq, int T, const float* X, const float* s0, const float* pk, const float* pv, const float* buf0, int P,
                      float* Yout, float* Kout, float* Vout, float* Sout, float* Cout, unsigned char* wsb) {
    const int R = nseq * T;
    const size_t SL = (size_t)2048 * 1024 * 4;
    float* PRM = (float*)wsb;
    auto slot = [&](double i) { return (float*)(wsb + 65536 + (size_t)(i * SL)); };
    const float* w_in = p.in[6];
    auto gemm = [&](const float* A, int lda, const float* B, int ldb, float* C, int ldc, int N, int K) { hipLaunchKernelGGL(sgemm, dim3(N / 128, R / 128), dim3(256), 0, st, A, lda, B, ldb, C, ldc, K); };
    hipLaunchKernelGGL(params_k, dim3(4), dim3(256), 0, st, p.in[7], p.in[9], p.in[10], p.in[11], p.in[12], PRM);
    float *HQ = slot(0), *HF = slot(1), *HI = slot(2), *HOG = slot(3), *OH = slot(4), *YHG = slot(5);
    gemm(X, 1024, w_in + 0, INW, HQ, 1024, 1024, 1024);
    gemm(X, 1024, w_in + 1024, INW, HF, 1024, 1024, 1024);
    gemm(X, 1024, w_in + 2048, INW, HI, 1024, 1024, 1024);
    gemm(X, 1024, w_in + 3072, INW, HOG, 1024, 1024, 1024);
    hipLaunchKernelGGL(hgrn_k, dim3(nseq * 8), dim3(256), 0, st, HQ, HF, HI, PRM, s0, OH, Sout, T);
    hipLaunchKernelGGL(rms_gate_k, dim3(R * 8 / 4), dim3(256), 0, st, OH, p.in[8], HOG, 1.f, YHG, R);
    float *DQ = slot(0), *AO = slot(1), *YDA = slot(2);
    gemm(X, 1024, w_in + 4096, INW, DQ, 1024, 1024, 1024);
    gemm(X, 1024, w_in + 5120, INW, Kout, 1024, 1024, 1024);
    gemm(X, 1024, w_in + 6144, INW, Vout, 1024, 1024, 1024);
    hipLaunchKernelGGL(attn_k, dim3(R * 8 / 4), dim3(256), (size_t)4 * 2 * (P + T) * 4, st, DQ, Kout, Vout, pk, pv, PRM, AO, T, P, R);
    hipLaunchKernelGGL(rms_gate_k, dim3(R * 8 / 4), dim3(256), 0, st, AO, p.in[13], (const float*)nullptr, 1.f - LAM_INIT, YDA, R);
    float *G1 = slot(0), *G2 = slot(1), *T1 = slot(3), *T2 = slot(4), *MM = slot(6), *PRE = slot(0), *H = slot(1);
    gemm(X, 1024, w_in + 7168, INW, G1, 1024, 1024, 1024);
    gemm(X, 1024, w_in + 8192, INW, G2, 1024, 1024, 1024);
    gemm(YHG, 1024, p.in[14], 1024, T1, 1024, 1024, 1024);
    gemm(YDA, 1024, p.in[15], 1024, T2, 1024, 1024, 1024);
    hipLaunchKernelGGL(merge_k, dim3(1024), dim3(256), 0, st, G1, T1, G2, T2, MM, (size_t)R * 1024);
    gemm(MM, 1024, p.in[16], 1024, PRE, 1024, 1024, 1024);
    hipLaunchKernelGGL(ln_k, dim3(R / 4), dim3(256), 0, st, X, PRE, p.in[17], p.in[18], H, R);
    float *UV = slot(2), *UG = slot(4), *ACT = slot(6);
    for (int half = 0; half < 2; ++half) {
        const int c0 = half * 1408;
        gemm(H, 1024, p.in[19] + c0, 5632, UV, 1408, 1408, 1024);
        gemm(H, 1024, p.in[19] + 2816 + c0, 5632, UG, 1408, 1408, 1024);
        hipLaunchKernelGGL(convgate_k, dim3(2048), dim3(256), 0, st, UV, UG, buf0, p.in[20], p.in[21], ACT, Cout, T, 1408, c0, R);
    }
    float* PRE2 = slot(0);
    gemm(ACT, 2816, p.in[22], 1024, PRE2, 1024, 1024, 2816);
    hipLaunchKernelGGL(ln_k, dim3(R / 4), dim3(256), 0, st, H, PRE2, p.in[23], p.in[24], Yout, R);
}

constexpr size_t O_YP = 0, O_YS = 16777216, O_KP = 17825792, O_VP = 34603008, O_SP = 51380224, O_CP = 52428800, O_KS = 52518912, O_VS = 53567488, O_SS = 54616064, O_CS = 56713216;

static void run_all(void* const* d_in, float* out, unsigned char* wsb, hipStream_t st) {
    Ptrs p{}; for (int i = 0; i < 25; ++i) p.in[i] = (const float*)d_in[i]; p.out = out; p.ws = wsb;
    for (int b = 0; b < 8; ++b)
        run_group(p, st, 1, 2048, p.in[0] + (size_t)b * 2048 * 1024, nullptr, nullptr, nullptr, nullptr, 0,
                  out + O_YP + (size_t)b * 2048 * 1024, out + O_KP + (size_t)b * 2048 * 1024, out + O_VP + (size_t)b * 2048 * 1024,
                  out + O_SP + (size_t)b * 8 * 128 * 128, out + O_CP + (size_t)b * 2 * 5632, wsb);
    run_group(p, st, 16, 64, p.in[1], p.in[4], p.in[2], p.in[3], p.in[5], 2048,
              out + O_YS, out + O_KS, out + O_VS, out + O_SS, out + O_CS, wsb);
}
}
extern "C" void kernel_launch(void* const* d_in, const int* in_sizes, int n_in, void* d_out, int out_size, void* d_ws, size_t ws_size, hipStream_t stream) {
    static int init = 0;
    if (!init) { (void)hipFuncSetAttribute((const void*)slow::attn_k, hipFuncAttributeMaxDynamicSharedMemorySize, 72 * 1024); init = 1; }
    slow::run_all(d_in, (float*)d_out, (unsigned char*)d_ws, stream);
}
```

```cpp
#include <hip/hip_runtime.h>
#include <hip/hip_cooperative_groups.h>
#include <cstdio>
#include <cstdint>
#include <type_traits>
#define ONE_LAUNCH (1 != 0)
namespace pg8 {
#define PG8_LAS __attribute__((address_space(3)))
typedef unsigned short bf16_t;
typedef short bf16x8 __attribute__((ext_vector_type(8)));
typedef float f32x4 __attribute__((ext_vector_type(4)));
typedef unsigned u32x4 __attribute__((ext_vector_type(4)));
constexpr int BM = 256, BK = 64, HALF = 128, HTB = HALF * BK * 2  , STAGE_BYTES = 8 * HTB, NXCD = 8, WGM = 8;

__host__ __device__ __forceinline__ int lds_byte(int r, int c) { const int st = (r >> 4) * 2 + (c >> 5), rr = r & 15, cc = c & 31, ob = rr * 64 + cc * 2; return st * 1024 + (ob ^ (((ob >> 9) & 1) << 5)); }
__host__ __device__ __forceinline__ void stage_rc(int b, int& R, int& C) { const int st = b / 1024, sb = b % 1024, swz = sb ^ (((sb >> 9) & 1) << 5); R = (st >> 1) * 16 + swz / 64; C = (st & 1) * 32 + (swz % 64) / 2; }
__host__ __device__ __forceinline__ int perm32(int rho) { const int n = rho >> 4, i = rho & 15; return 8 * (i >> 2) + 4 * n + (i & 3); }

struct Unit { int pm, pn; };
struct Gemm { const bf16_t* A; const bf16_t* Bt; int M, N, K; };

struct StaticOrder {
    int nM, nN, nwg, G, c;
    __host__ __device__ void init(int M, int N, int G_, int c_) { nM = M / BM; nN = N / BM; nwg = nM * nN; G = G_; c = c_; }
    __host__ __device__ bool next(int i, Unit& u) const {
        const long L = (long)i * G + c; if (L >= nwg) return false;
        int wgid = (int)L; { const int q = nwg / NXCD, r = nwg % NXCD, xcd = wgid % NXCD, off = wgid / NXCD; wgid = (xcd < r ? xcd * (q + 1) : r * (q + 1) + (xcd - r) * q) + off; }
        const int nig = WGM * nN, gid = wgid / nig, fm = gid * WGM, gsz = (nM - fm) < WGM ? (nM - fm) : WGM;
        u.pm = fm + ((wgid % nig) % gsz); u.pn = (wgid % nig) / gsz; return true;
    }
    __device__ __forceinline__ void a_ready(const Unit&) const {}
    __device__ __forceinline__ void done(const Unit&) const {}
};

__device__ __forceinline__ unsigned cvt_pk_bf16(float lo, float hi) { unsigned r; asm volatile("v_cvt_pk_bf16_f32 %0, %1, %2" : "=v"(r) : "v"(lo), "v"(hi)); return r; }
__device__ __forceinline__ float sigm(float v) { return __builtin_amdgcn_rcpf(1.f + __builtin_amdgcn_exp2f(-1.4426950408889634f * v)); }
__device__ __forceinline__ float bf_lo(unsigned w) { return __uint_as_float(w << 16); }
__device__ __forceinline__ float bf_hi(unsigned w) { return __uint_as_float(w & 0xffff0000u); }
constexpr int MP_ROWS = 16384;
constexpr float ALPHA_DN = 1.189207115002721f;

struct EpiIn {
    static constexpr bool PERM = true, AFTER_DRAIN = false, HAS_MID = false; static constexpr int MID_T = 0;
    bf16_t *QH, *VH, *OG, *DQ, *DK, *DV, *GH, *GD; float* LOGF; const float* lb; float *kp, *ks, *vp, *vs;
    __device__ __forceinline__ void operator()(const f32x4 (&acc)[2][2][4][2], const Unit& u, int wr, int wc, int fr, int fq) const {
        const int seg = u.pn >> 2, colt = (u.pn & 3) * BM;
        const int row0 = u.pm * BM + wr * 64 + fr, col0 = colt + wc * 32 + 8 * fq;
        bf16_t* ob = seg == 0 ? QH : seg == 2 ? VH : seg == 3 ? OG : seg == 4 ? DQ : seg == 5 ? DK : seg == 6 ? DV : seg == 7 ? GH : GD;
        const bool sg = (seg == 3) | (seg >= 7);
        if (seg == 1) {
            f32x4 l0[2], l1[2];
#pragma unroll
            for (int bj = 0; bj < 2; ++bj) { l0[bj] = *(const f32x4*)(lb + col0 + bj * HALF); l1[bj] = *(const f32x4*)(lb + col0 + bj * HALF + 4); }
#pragma unroll
            for (int ai = 0; ai < 2; ++ai)
#pragma unroll
                for (int m = 0; m < 4; ++m) { float* rowp = LOGF + (size_t)(row0 + ai * HALF + m * 16) * 1024 + col0;
#pragma unroll
                    for (int bj = 0; bj < 2; ++bj) { f32x4 v0 = acc[ai][bj][m][0], v1 = acc[ai][bj][m][1];
#pragma unroll
                        for (int e = 0; e < 4; ++e) { v0[e] = __builtin_amdgcn_logf(l0[bj][e] + (1.f - l0[bj][e]) * sigm(v0[e])); v1[e] = __builtin_amdgcn_logf(l1[bj][e] + (1.f - l1[bj][e]) * sigm(v1[e])); }
                        *(f32x4*)(rowp + bj * HALF) = v0; *(f32x4*)(rowp + bj * HALF + 4) = v1; } }
            return;
        }
        float* fo = nullptr;
        if (seg == 5) fo = (u.pm < 64) ? kp : ks - (size_t)MP_ROWS * 1024;
        if (seg == 6) fo = (u.pm < 64) ? vp : vs - (size_t)MP_ROWS * 1024;
#pragma unroll
        for (int ai = 0; ai < 2; ++ai)
#pragma unroll
            for (int m = 0; m < 4; ++m) { const size_t ro = (size_t)(row0 + ai * HALF + m * 16) * 1024 + col0;
#pragma unroll
                for (int bj = 0; bj < 2; ++bj) { f32x4 v0 = acc[ai][bj][m][0], v1 = acc[ai][bj][m][1];
                    if (sg) {
#pragma unroll
                        for (int e = 0; e < 4; ++e) { v0[e] = sigm(v0[e]); v1[e] = sigm(v1[e]); } }
                    if (fo) { *(f32x4*)(fo + ro + bj * HALF) = v0; *(f32x4*)(fo + ro + bj * HALF + 4) = v1; }
                    u32x4 w; w.x = cvt_pk_bf16(v0[0], v0[1]); w.y = cvt_pk_bf16(v0[2], v0[3]); w.z = cvt_pk_bf16(v1[0], v1[1]); w.w = cvt_pk_bf16(v1[2], v1[3]);
                    *(u32x4*)(ob + ro + bj * HALF) = w; } }
    }
};

struct EpiBr {
    static constexpr bool PERM = true, AFTER_DRAIN = false, HAS_MID = true; static constexpr int MID_T = 16;
    const bf16_t *GH, *GD; bf16_t* MB;
    __device__ __forceinline__ void mid(f32x4 (&acc)[2][2][4][2], const Unit& u, int wr, int wc, int fr, int fq) const {
        int row0 = u.pm * BM + wr * 64 + fr, col0 = u.pn * BM + wc * 32 + 8 * fq;
        asm volatile("" : "+v"(row0), "+v"(col0));
#pragma unroll
        for (int ai = 0; ai < 2; ++ai)
#pragma unroll
            for (int m = 0; m < 4; ++m) { const size_t ro = (size_t)(row0 + ai * HALF + m * 16) * 1024 + col0;
#pragma unroll
                for (int bj = 0; bj < 2; ++bj) { const u32x4 a = *(const u32x4*)(GH + ro + bj * HALF), b = *(const u32x4*)(GD + ro + bj * HALF);
                    f32x4& v0 = acc[ai][bj][m][0]; f32x4& v1 = acc[ai][bj][m][1];
                    v0[0] *= bf_lo(a.x) * __builtin_amdgcn_rcpf(bf_lo(b.x)); v0[1] *= bf_hi(a.x) * __builtin_amdgcn_rcpf(bf_hi(b.x));
                    v0[2] *= bf_lo(a.y) * __builtin_amdgcn_rcpf(bf_lo(b.y)); v0[3] *= bf_hi(a.y) * __builtin_amdgcn_rcpf(bf_hi(b.y));
                    v1[0] *= bf_lo(a.z) * __builtin_amdgcn_rcpf(bf_lo(b.z)); v1[1] *= bf_hi(a.z) * __builtin_amdgcn_rcpf(bf_hi(b.z));
                    v1[2] *= bf_lo(a.w) * __builtin_amdgcn_rcpf(bf_lo(b.w)); v1[3] *= bf_hi(a.w) * __builtin_amdgcn_rcpf(bf_hi(b.w)); }
                asm volatile("" ::: "memory"); }
    }
    __device__ __forceinline__ void operator()(const f32x4 (&acc)[2][2][4][2], const Unit& u, int wr, int wc, int fr, int fq) const {
        const int row0 = u.pm * BM + wr * 64 + fr, col0 = u.pn * BM + wc * 32 + 8 * fq;
#pragma unroll
        for (int ai = 0; ai < 2; ++ai)
#pragma unroll
            for (int m = 0; m < 4; ++m) { const size_t ro = (size_t)(row0 + ai * HALF + m * 16) * 1024 + col0;
#pragma unroll
                for (int bj = 0; bj < 2; ++bj) { const u32x4 b = *(const u32x4*)(GD + ro + bj * HALF); const f32x4 v0 = acc[ai][bj][m][0], v1 = acc[ai][bj][m][1];
                    u32x4 w; w.x = cvt_pk_bf16(v0[0] * bf_lo(b.x), v0[1] * bf_hi(b.x)); w.y = cvt_pk_bf16(v0[2] * bf_lo(b.y), v0[3] * bf_hi(b.y));
                    w.z = cvt_pk_bf16(v1[0] * bf_lo(b.z), v1[1] * bf_hi(b.z)); w.w = cvt_pk_bf16(v1[2] * bf_lo(b.w), v1[3] * bf_hi(b.w));
                    *(u32x4*)(MB + ro + bj * HALF) = w; } }
    }
};

struct EpiRes {
    static constexpr bool PERM = false, AFTER_DRAIN = false, HAS_MID = false; static constexpr int MID_T = 0;
    const float *base0, *base1; float* O;
    __device__ __forceinline__ void operator()(const f32x4 (&acc)[2][2][4][2], const Unit& u, int wr, int wc, int fr, int fq) const {
        const int row0 = u.pm * BM + wr * 64 + fr, col0 = u.pn * BM + wc * 32 + 4 * fq;
        const float* bs = (u.pm < 64) ? base0 : base1 - (size_t)MP_ROWS * 1024;
#pragma unroll
        for (int ai = 0; ai < 2; ++ai)
#pragma unroll
            for (int m = 0; m < 4; ++m) { const size_t ro = (size_t)(row0 + ai * HALF + m * 16) * 1024 + col0;
#pragma unroll
                for (int bj = 0; bj < 2; ++bj)
#pragma unroll
                    for (int n = 0; n < 2; ++n) { const f32x4 x = *(const f32x4*)(bs + ro + bj * HALF + n * 16);
                        *(f32x4*)(O + ro + bj * HALF + n * 16) = x * ALPHA_DN + acc[ai][bj][m][n]; } }
    }
};

struct EpiUp {
    static constexpr bool PERM = true, AFTER_DRAIN = false, HAS_MID = false; static constexpr int MID_T = 0;
    bf16_t* UP; float *cp, *cs;
    __device__ __forceinline__ void operator()(const f32x4 (&acc)[2][2][4][2], const Unit& u, int wr, int wc, int fr, int fq) const {
        const int row0 = u.pm * BM + wr * 64 + fr, col0 = u.pn * BM + wc * 32 + 8 * fq;
#pragma unroll
        for (int ai = 0; ai < 2; ++ai)
#pragma unroll
            for (int m = 0; m < 4; ++m) { const int r = row0 + ai * HALF + m * 16; const size_t ro = (size_t)r * 5632 + col0;
                float* so = nullptr;
                if (r < MP_ROWS) { const int t = r & 2047; if (t >= 2046) so = cp + ((size_t)(r >> 11) * 2 + (t - 2046)) * 5632 + col0; }
                else { const int rr = r - MP_ROWS, t = rr & 63; if (t >= 62) so = cs + ((size_t)(rr >> 6) * 2 + (t - 62)) * 5632 + col0; }
#pragma unroll
                for (int bj = 0; bj < 2; ++bj) { const f32x4 v0 = acc[ai][bj][m][0], v1 = acc[ai][bj][m][1];
                    if (so) { *(f32x4*)(so + bj * HALF) = v0; *(f32x4*)(so + bj * HALF + 4) = v1; }
                    u32x4 w; w.x = cvt_pk_bf16(v0[0], v0[1]); w.y = cvt_pk_bf16(v0[2], v0[3]); w.z = cvt_pk_bf16(v1[0], v1[1]); w.w = cvt_pk_bf16(v1[2], v1[3]);
                    *(u32x4*)(UP + ro + bj * HALF) = w; } }
    }
};
template <class Epi, class Sched, bool ALIGN_EPI = false, bool SP2 = false>
__device__ __forceinline__ void gemm_phase(PG8_LAS unsigned char* lds, const Gemm g, const Sched& S, const Epi& E) {
    const int tid = threadIdx.x, wid = __builtin_amdgcn_readfirstlane(tid >> 6), lane = tid & 63, wr = wid >> 2, wc = wid & 3, fr = lane & 15, fq = lane >> 4;
    const int K = g.K, nt = K / BK;
    unsigned voffA[2], voffB[2];
#pragma unroll
    for (int i = 0; i < 2; ++i) { int R, C; stage_rc(tid * 16 + i * 8192, R, C); const int Rb = Epi::PERM ? ((R & ~31) + perm32(R & 31)) : R;
        voffA[i] = (unsigned)(R * K + C) * 2u; voffB[i] = (unsigned)(Rb * K + C) * 2u; }
    const size_t kstep = (size_t)(BK * 2);
    const size_t hstep = (size_t)HALF * K * 2;
    const size_t tstep = 2 * hstep;
    const unsigned ldsw = (unsigned)wid * 1024u;
    const int aoff = lds_byte(wr * 64 + fr, fq * 8), boff = lds_byte(wc * 32 + fr, fq * 8);
#define PG8_SA(b, h) (((b) * 2 + (h)) * HTB)
#define PG8_SB(b, h) ((4 + (b) * 2 + (h)) * HTB)
#define PG8_STAGE(bufoff, gbase, voff) do { _Pragma("unroll") for (int _i = 0; _i < 2; ++_i) \
        __builtin_amdgcn_global_load_lds((const unsigned*)((const char*)(gbase) + (voff)[_i]), (PG8_LAS unsigned*)(lds + (bufoff) + ldsw + _i * 8192), 16, 0, 0); } while (0)
#define PG8_LDA(dst, b, h) do { _Pragma("unroll") for (int m = 0; m < 4; ++m) _Pragma("unroll") for (int k = 0; k < 2; ++k) dst[m][k] = *(const PG8_LAS bf16x8*)(lds + PG8_SA(b, h) + aoff + m * 2048 + k * 1024); } while (0)
#define PG8_LDB(dst, b, h) do { _Pragma("unroll") for (int n = 0; n < 2; ++n) _Pragma("unroll") for (int k = 0; k < 2; ++k) dst[n][k] = *(const PG8_LAS bf16x8*)(lds + PG8_SB(b, h) + boff + n * 2048 + k * 1024); } while (0)
#define PG8_MMA(ai, bj, At, Bt) do { __builtin_amdgcn_s_setprio(1); _Pragma("unroll") for (int m = 0; m < 4; ++m) _Pragma("unroll") for (int n = 0; n < 2; ++n) _Pragma("unroll") for (int k = 0; k < 2; ++k) \
        acc[ai][bj][m][n] = __builtin_amdgcn_mfma_f32_16x16x32_bf16(Bt[n][k], At[m][k], acc[ai][bj][m][n], 0, 0, 0); __builtin_amdgcn_s_setprio(0); } while (0)
#define PG8_WAIT_V(n) asm volatile("s_waitcnt vmcnt(" #n ")" ::: "memory")
#define PG8_WAIT_L(n) asm volatile("s_waitcnt lgkmcnt(" #n ")" ::: "memory")
#define PG8_BAR __builtin_amdgcn_s_barrier()
#define PG8_SCHED __builtin_amdgcn_sched_barrier(0)
    Unit cur, nxt; int ui = 0;
    if (!S.next(0, cur)) return;
    f32x4 acc[2][2][4][2];
#pragma unroll
    for (int a = 0; a < 2; ++a)
#pragma unroll
        for (int b = 0; b < 2; ++b)
#pragma unroll
            for (int m = 0; m < 4; ++m)
#pragma unroll
                for (int n = 0; n < 2; ++n) acc[a][b][m][n] = (f32x4){0.f, 0.f, 0.f, 0.f};
    bf16x8 At[4][2], B0[2][2], B1[2][2];
    const char* cA = (const char*)g.A + (size_t)cur.pm * tstep; const char* cB = (const char*)g.Bt + (size_t)cur.pn * tstep;
    S.a_ready(cur);
    if constexpr (SP2) {
        PG8_STAGE(PG8_SB(0, 0), cB, voffB); PG8_STAGE(PG8_SB(0, 1), cB + hstep, voffB); PG8_STAGE(PG8_SA(0, 0), cA, voffA); PG8_STAGE(PG8_SA(0, 1), cA + hstep, voffA);
        if (wr == 1) PG8_BAR;
        PG8_WAIT_V(2); PG8_BAR;
        PG8_STAGE(PG8_SB(1, 0), cB + kstep, voffB); PG8_STAGE(PG8_SA(1, 0), cA + kstep, voffA); PG8_STAGE(PG8_SB(1, 1), cB + hstep + kstep, voffB);
        PG8_WAIT_V(6); PG8_BAR;
    } else {
        PG8_STAGE(PG8_SB(0, 0), cB, voffB); PG8_STAGE(PG8_SA(0, 0), cA, voffA); PG8_STAGE(PG8_SB(0, 1), cB + hstep, voffB); PG8_STAGE(PG8_SA(0, 1), cA + hstep, voffA);
        if (wr == 1) PG8_BAR;
        PG8_WAIT_V(4); PG8_BAR;
        PG8_STAGE(PG8_SB(1, 0), cB + kstep, voffB); PG8_STAGE(PG8_SA(1, 0), cA + kstep, voffA); PG8_STAGE(PG8_SB(1, 1), cB + hstep + kstep, voffB);
        PG8_WAIT_V(6); PG8_BAR;
    }
    for (;;) {
        const bool has_next = S.next(ui + 1, nxt);
        const char* nA = has_next ? (const char*)g.A + (size_t)nxt.pm * tstep : cA; const char* nB = has_next ? (const char*)g.Bt + (size_t)nxt.pn * tstep : cB;
        for (int t = 0; t < nt; t += 2) {
            const bool last = (t == nt - 2);
            if constexpr (Epi::HAS_MID) { if (t == Epi::MID_T) E.mid(acc, cur, wr, wc, fr, fq); }
            const char* a1 = cA + (size_t)(t + 1) * kstep;
            const char* a2 = last ? nA : cA + (size_t)(t + 2) * kstep; const char* b2 = last ? nB : cB + (size_t)(t + 2) * kstep;
            const char* a3 = a2 + kstep; const char* b3 = b2 + kstep;
            if (last && has_next) S.a_ready(nxt);
            if constexpr (SP2) {
            PG8_LDB(B0, 0, 0); PG8_LDB(B1, 0, 1); PG8_SCHED; PG8_LDA(At, 0, 0); PG8_STAGE(PG8_SA(1, 1), a1 + hstep, voffA);
            PG8_WAIT_V(8); PG8_WAIT_L(0); PG8_BAR; PG8_MMA(0, 0, At, B0); PG8_MMA(0, 1, At, B1); PG8_BAR; PG8_SCHED;
            PG8_LDA(At, 0, 1); PG8_STAGE(PG8_SB(0, 0), b2, voffB); PG8_STAGE(PG8_SB(0, 1), b2 + hstep, voffB); PG8_STAGE(PG8_SA(0, 0), a2, voffA);
            PG8_WAIT_V(8); PG8_WAIT_L(0); PG8_BAR; PG8_MMA(1, 0, At, B0); PG8_MMA(1, 1, At, B1); PG8_BAR; PG8_SCHED;
            PG8_LDB(B0, 1, 0); PG8_LDB(B1, 1, 1); PG8_SCHED; PG8_LDA(At, 1, 0); PG8_STAGE(PG8_SA(0, 1), a2 + hstep, voffA);
            PG8_WAIT_V(8); PG8_WAIT_L(0); PG8_BAR; PG8_MMA(0, 0, At, B0); PG8_MMA(0, 1, At, B1); PG8_BAR; PG8_SCHED;
            PG8_LDA(At, 1, 1); PG8_STAGE(PG8_SB(1, 0), b3, voffB); PG8_STAGE(PG8_SB(1, 1), b3 + hstep, voffB); PG8_STAGE(PG8_SA(1, 0), a3, voffA);
            PG8_WAIT_V(8); PG8_WAIT_L(0); PG8_BAR; PG8_MMA(1, 0, At, B0); PG8_MMA(1, 1, At, B1); PG8_BAR; PG8_SCHED;
            } else {
            PG8_LDB(B0, 0, 0); PG8_SCHED; PG8_LDA(At, 0, 0); PG8_STAGE(PG8_SA(1, 1), a1 + hstep, voffA);
            PG8_WAIT_L(8); PG8_BAR; PG8_WAIT_L(0); PG8_MMA(0, 0, At, B0); PG8_BAR; PG8_SCHED;
            PG8_LDB(B1, 0, 1); PG8_STAGE(PG8_SB(0, 0), b2, voffB);
            PG8_BAR; PG8_WAIT_L(0); PG8_MMA(0, 1, At, B1); PG8_BAR;
            PG8_LDA(At, 0, 1); PG8_STAGE(PG8_SA(0, 0), a2, voffA);
            PG8_BAR; PG8_WAIT_L(0); PG8_MMA(1, 0, At, B0); PG8_BAR; PG8_SCHED;
            PG8_STAGE(PG8_SB(0, 1), b2 + hstep, voffB);
            PG8_WAIT_V(6); PG8_BAR; PG8_MMA(1, 1, At, B1); PG8_BAR;
            PG8_LDB(B0, 1, 0); PG8_SCHED; PG8_LDA(At, 1, 0); PG8_STAGE(PG8_SA(0, 1), a2 + hstep, voffA);
            PG8_WAIT_L(8); PG8_BAR; PG8_WAIT_L(0); PG8_MMA(0, 0, At, B0); PG8_BAR; PG8_SCHED;
            PG8_LDB(B1, 1, 1); PG8_STAGE(PG8_SB(1, 0), b3, voffB);
            PG8_BAR; PG8_WAIT_L(0); PG8_MMA(0, 1, At, B1); PG8_BAR;
            PG8_LDA(At, 1, 1); PG8_STAGE(PG8_SA(1, 0), a3, voffA);
            PG8_BAR; PG8_WAIT_L(0); PG8_MMA(1, 0, At, B0); PG8_BAR; PG8_SCHED;
            PG8_STAGE(PG8_SB(1, 1), b3 + hstep, voffB);
            PG8_WAIT_V(6); PG8_BAR; PG8_MMA(1, 1, At, B1); PG8_BAR;
            }
        }
        if constexpr (ALIGN_EPI) { if (wr == 0) PG8_BAR; }
        if constexpr (!Epi::AFTER_DRAIN) { E(acc, cur, wr, wc, fr, fq); S.done(cur); }
        if (!has_next) break;
#pragma unroll
        for (int a = 0; a < 2; ++a)
#pragma unroll
            for (int b = 0; b < 2; ++b)
#pragma unroll
                for (int m = 0; m < 4; ++m)
#pragma unroll
                    for (int n = 0; n < 2; ++n) acc[a][b][m][n] = (f32x4){0.f, 0.f, 0.f, 0.f};
        cur = nxt; cA = nA; cB = nB; ++ui;
        if constexpr (ALIGN_EPI) { if (wr == 1) PG8_BAR; }
    }
    PG8_WAIT_V(0);
    if constexpr (!ALIGN_EPI) { if (wr == 0) PG8_BAR; }
    PG8_BAR;
    if constexpr (Epi::AFTER_DRAIN) { E.fused(acc, cur, wr, wc, fr, fq, lds, wid, lane); S.done(cur); }
#undef PG8_SA
#undef PG8_SB
#undef PG8_STAGE
#undef PG8_LDA
#undef PG8_LDB
#undef PG8_MMA
#undef PG8_WAIT_V
#undef PG8_WAIT_L
#undef PG8_BAR
#undef PG8_SCHED
}
}
namespace mix {
constexpr int MP_ROWS = 16384;
using bf16x8 = __attribute__((ext_vector_type(8))) short;
using s16x4  = __attribute__((ext_vector_type(4))) short;
using f32x16 = __attribute__((ext_vector_type(16))) float;
using f32x8  = __attribute__((ext_vector_type(8))) float;
using f32x4  = __attribute__((ext_vector_type(4))) float;
using f32x2  = __attribute__((ext_vector_type(2))) float;
using u32x4  = __attribute__((ext_vector_type(4))) unsigned;
using u32x2  = __attribute__((ext_vector_type(2))) unsigned;
typedef unsigned short bf16_t;
#define KSWZ(row, colB) ((row) * 256 + ((colB) ^ (((row) & 7) << 4)))
#define SBAR() __builtin_amdgcn_sched_barrier(0)
constexpr float LN_EPS = 1e-5f;
constexpr size_t O_YP = 0, O_YS = 16777216, O_KP = 17825792, O_VP = 34603008, O_SP = 51380224, O_CP = 52428800, O_KS = 52518912, O_VS = 53567488, O_SS = 54616064, O_CS = 56713216;

__device__ __forceinline__ int crow(int r, int hi) { return (r & 3) + 8 * (r >> 2) + 4 * hi; }
__device__ __forceinline__ unsigned cvtpk(float lo, float hi) { unsigned r; asm volatile("v_cvt_pk_bf16_f32 %0, %1, %2" : "=v"(r) : "v"(lo), "v"(hi)); return r; }
__device__ __forceinline__ bf16x8 tobf(f32x8 x) { u32x4 w = {cvtpk(x[0], x[1]), cvtpk(x[2], x[3]), cvtpk(x[4], x[5]), cvtpk(x[6], x[7])}; return __builtin_bit_cast(bf16x8, w); }
__device__ __forceinline__ float bflo(unsigned w) { return __uint_as_float(w << 16); }
__device__ __forceinline__ float bfhi(unsigned w) { return __uint_as_float(w & 0xffff0000u); }
__device__ __forceinline__ int v_st(int k, int c) { const int kk = (k & ~0xC) | ((k & 4) << 1) | ((k & 8) >> 1); return ((kk >> 3) * 4 + (c >> 5)) * 512 + ((kk & 7) * 32 + (c & 31)) * 2; }
__device__ __forceinline__ int v_rd_base(int lane) { return ((lane & 3) << 3) | (((lane >> 2) & 3) << 6) | (((lane >> 4) & 1) << 5) | (((lane >> 5) & 1) << 8); }
template <int OFF> __device__ __forceinline__ s16x4 tr_read(int vb) { s16x4 r; asm volatile("ds_read_b64_tr_b16 %0, %1 offset:%2" : "=&v"(r) : "v"(vb), "i"(OFF) : "memory"); return r; }
#define PKF(L, H) (bf16x8){L[0], L[1], L[2], L[3], H[0], H[1], H[2], H[3]}
#define PK4(P, BASE, OUT) do { unsigned a0_ = cvtpk(P[BASE + 0], P[BASE + 1]), a1_ = cvtpk(P[BASE + 2], P[BASE + 3]);   \
    unsigned b0_ = cvtpk(P[BASE + 4], P[BASE + 5]), b1_ = cvtpk(P[BASE + 6], P[BASE + 7]);                              \
    auto r0_ = __builtin_amdgcn_permlane32_swap(a0_, b0_, false, false); auto r1_ = __builtin_amdgcn_permlane32_swap(a1_, b1_, false, false); \
    u32x4 w_ = {r0_[0], r1_[0], r0_[1], r1_[1]}; OUT = __builtin_bit_cast(bf16x8, w_); } while (0)

template <int D0> __device__ __forceinline__ void pv_one(f32x16& od, int vb, bf16x8 pa0, bf16x8 pa1, bf16x8 pa2, bf16x8 pa3) {
    const s16x4 l0 = tr_read<D0 * 512 + 0>(vb), h0 = tr_read<D0 * 512 + 2048>(vb), l1 = tr_read<D0 * 512 + 4096>(vb), h1 = tr_read<D0 * 512 + 4096 + 2048>(vb);
    const s16x4 l2 = tr_read<D0 * 512 + 8192>(vb), h2 = tr_read<D0 * 512 + 8192 + 2048>(vb), l3 = tr_read<D0 * 512 + 12288>(vb), h3 = tr_read<D0 * 512 + 12288 + 2048>(vb);
    asm volatile("s_waitcnt lgkmcnt(0)" ::: "memory"); SBAR();
    od = __builtin_amdgcn_mfma_f32_32x32x16_bf16(pa0, PKF(l0, h0), od, 0, 0, 0);
    od = __builtin_amdgcn_mfma_f32_32x32x16_bf16(pa1, PKF(l1, h1), od, 0, 0, 0);
    od = __builtin_amdgcn_mfma_f32_32x32x16_bf16(pa2, PKF(l2, h2), od, 0, 0, 0);
    od = __builtin_amdgcn_mfma_f32_32x32x16_bf16(pa3, PKF(l3, h3), od, 0, 0, 0);
}

struct Ctx {
    const bf16_t *QH, *VH, *OG, *DQ, *DK, *DV; const float* LOGF; bf16_t* YY;
    const float *cache_k, *cache_v, *state0, *gnorm, *gsub, *prm; float* out;
};

template <int R, bool GATE>
__device__ __forceinline__ void row_epilogue(const float* T, const float* g, float cst, const bf16_t* gate_rows  , bf16_t* yrows  ) {
    constexpr int TPR = 512 / R, CPT = 128 / TPR;
    const int tid = threadIdx.x, row = tid / TPR, c0 = (tid % TPR) * CPT;
    float v[CPT]; float ss = 0.f;
#pragma unroll
    for (int i = 0; i < CPT; i += 4) { const f32x4 x = *(const f32x4*)(T + row * 132 + c0 + i); v[i] = x[0]; v[i + 1] = x[1]; v[i + 2] = x[2]; v[i + 3] = x[3]; ss += x[0] * x[0] + x[1] * x[1] + x[2] * x[2] + x[3] * x[3]; }
#pragma unroll
    for (int o = 1; o < TPR; o <<= 1) ss += __shfl_xor(ss, o);
    const float rs = __builtin_amdgcn_rsqf(ss * (1.f / 128.f) + LN_EPS) * cst;
#pragma unroll
    for (int i = 0; i < CPT; i += 8) {
        const f32x4 g0 = *(const f32x4*)(g + c0 + i), g1 = *(const f32x4*)(g + c0 + i + 4);
        float m[8] = {g0[0], g0[1], g0[2], g0[3], g1[0], g1[1], g1[2], g1[3]};
        if (GATE) { const u32x4 gg = *(const u32x4*)(gate_rows + (size_t)row * 1024 + c0 + i);
            m[0] *= bflo(gg.x); m[1] *= bfhi(gg.x); m[2] *= bflo(gg.y); m[3] *= bfhi(gg.y); m[4] *= bflo(gg.z); m[5] *= bfhi(gg.z); m[6] *= bflo(gg.w); m[7] *= bfhi(gg.w); }
        u32x4 w; w.x = cvtpk(v[i] * rs * m[0], v[i + 1] * rs * m[1]); w.y = cvtpk(v[i + 2] * rs * m[2], v[i + 3] * rs * m[3]);
        w.z = cvtpk(v[i + 4] * rs * m[4], v[i + 5] * rs * m[5]); w.w = cvtpk(v[i + 6] * rs * m[6], v[i + 7] * rs * m[7]);
        *(u32x4*)(yrows + (size_t)row * 2048 + c0 + i) = w;
    }
}

template <bool SAMPLE>
__device__ __forceinline__ void attn_unit(const Ctx& X, int b, int h, int qb, char* lds) {
    int tid_ = threadIdx.x; asm volatile("" : "+v"(tid_));
    const int tid = tid_, wid = __builtin_amdgcn_readfirstlane(tid >> 6), lane = tid & 63, r32 = lane & 31, hi = lane >> 5;
    const int c = wid >> 2, g = wid & 3;
    constexpr int SHM = 16384;
    char* V_lds = lds; char* K_lds = lds + 2 * SHM;
    float* wsf = (float*)(lds + 122880) + wid * 64;
    const int grp = SAMPLE ? (g & 1) : g, par = g >> 1;
    const int rowq0 = SAMPLE ? (MP_ROWS + b * 64 + 32 * grp) : (b * 2048 + 128 * qb + 32 * g);
    const int NT = SAMPLE ? 33 : (2 * qb + 2);
    const int lastt = SAMPLE ? 32 : (2 * qb + (g >> 1));
    constexpr float C = 0.125f * 1.4426950408889634f;
    bf16x8 qr[4];
    { const bf16_t* Qw = X.DQ + (size_t)(rowq0 + r32) * 1024 + h * 128 + c * 64 + hi * 8;
#pragma unroll
      for (int d0 = 0; d0 < 4; ++d0) qr[d0] = *(const bf16x8*)(Qw + d0 * 16); }
    const int sr = tid >> 4, sc = (tid & 15) * 8, vst0 = v_st(sr, sc), vst1 = v_st(32 + sr, sc), kst0 = KSWZ(sr, sc * 2), kst1 = KSWZ(32 + sr, sc * 2);
    const int vb0 = (int)(uintptr_t)V_lds + v_rd_base(lane);
    typedef typename std::conditional<SAMPLE, f32x8, bf16x8>::type ST;
    ST vs0, vs1, ks0, ks1;
    auto sload = [&](int j) {
        if constexpr (SAMPLE) {
            const float *kp_, *vp_;
            if (j < 32) { const size_t o = ((size_t)(b * 2048 + 64 * j + sr)) * 1024 + h * 128 + sc; kp_ = X.cache_k + o; vp_ = X.cache_v + o; }
            else { const size_t o = ((size_t)(b * 64 + sr)) * 1024 + h * 128 + sc; kp_ = X.out + O_KS + o; vp_ = X.out + O_VS + o; }
            vs0 = *(const f32x8*)vp_; vs1 = *(const f32x8*)(vp_ + 32 * 1024); ks0 = *(const f32x8*)kp_; ks1 = *(const f32x8*)(kp_ + 32 * 1024);
        } else {
            const size_t o = ((size_t)(b * 2048 + 64 * j + sr)) * 1024 + h * 128 + sc;
            vs0 = *(const bf16x8*)(X.DV + o); vs1 = *(const bf16x8*)(X.DV + o + 32 * 1024); ks0 = *(const bf16x8*)(X.DK + o); ks1 = *(const bf16x8*)(X.DK + o + 32 * 1024);
        }
    };
    auto swrite = [&](int bufi) {
        bf16x8 a, b_, c_, d_;
        if constexpr (SAMPLE) { a = tobf(vs0); b_ = tobf(vs1); c_ = tobf(ks0); d_ = tobf(ks1); } else { a = vs0; b_ = vs1; c_ = ks0; d_ = ks1; }
        *(bf16x8*)(V_lds + bufi * SHM + vst0) = a; *(bf16x8*)(V_lds + bufi * SHM + vst1) = b_;
        *(bf16x8*)(K_lds + bufi * SHM + kst0) = c_; *(bf16x8*)(K_lds + bufi * SHM + kst1) = d_;
    };
    float m_reg = -1e30f, l_reg = 0.f; f32x16 o[4];
#pragma unroll
    for (int d = 0; d < 4; ++d)
#pragma unroll
        for (int r = 0; r < 16; ++r) o[d][r] = 0.f;
    sload(0); swrite(0);
    if (NT > 1) sload(1);
    __syncthreads();
    for (int j = 0; j < NT; ++j) {
        const int bufi = j & 1;
        if (j + 1 < NT) swrite(bufi ^ 1);
        if (j + 2 < NT) sload(j + 2);
        const bool act = SAMPLE ? ((j & 1) == par) : (j <= lastt);
        if (act) {
            const char* Ks = K_lds + bufi * SHM;
            f32x16 p0, p1;
#pragma unroll
            for (int r = 0; r < 16; ++r) { p0[r] = 0.f; p1[r] = 0.f; }
#pragma unroll
            for (int d0 = 0; d0 < 4; ++d0) { const int cb = (c * 64 + d0 * 16 + hi * 8) * 2;
                const bf16x8 b0 = *(const bf16x8*)(Ks + KSWZ(r32, cb)); const bf16x8 b1 = *(const bf16x8*)(Ks + KSWZ(32 + r32, cb));
                p0 = __builtin_amdgcn_mfma_f32_32x32x16_bf16(b0, qr[d0], p0, 0, 0, 0);
                p1 = __builtin_amdgcn_mfma_f32_32x32x16_bf16(b1, qr[d0], p1, 0, 0, 0); }
            float pmax = p0[0];
#pragma unroll
            for (int r = 1; r < 16; ++r) pmax = fmaxf(pmax, p0[r]);
#pragma unroll
            for (int r = 0; r < 16; ++r) pmax = fmaxf(pmax, p1[r]);
            { auto rr = __builtin_amdgcn_permlane32_swap(__float_as_uint(pmax), __float_as_uint(pmax), false, false); pmax = fmaxf(__uint_as_float(rr[0]), __uint_as_float(rr[1])); }
            const float mn = fmaxf(m_reg, pmax); const float alpha = __builtin_amdgcn_exp2f((m_reg - mn) * C); m_reg = mn;
            const float mnC = -mn * C; float ps = 0.f;
#pragma unroll
            for (int r = 0; r < 16; ++r) { p0[r] = __builtin_amdgcn_exp2f(fmaf(p0[r], C, mnC)); p1[r] = __builtin_amdgcn_exp2f(fmaf(p1[r], C, mnC)); ps += p0[r] + p1[r]; }
            { auto rr = __builtin_amdgcn_permlane32_swap(__float_as_uint(ps), __float_as_uint(ps), false, false); ps = __uint_as_float(rr[0]) + __uint_as_float(rr[1]); }
            l_reg = l_reg * alpha + ps;
            if (__any(alpha < 1.f)) { if (hi == 0) wsf[r32] = alpha; asm volatile("s_waitcnt lgkmcnt(0)" ::: "memory");
#pragma unroll
                for (int r = 0; r < 16; ++r) { const float a = wsf[crow(r, hi)];
#pragma unroll
                    for (int d = 0; d < 4; ++d) o[d][r] *= a; } }
            bf16x8 pa0, pa1, pa2, pa3;
            PK4(p0, 0, pa0); PK4(p0, 8, pa1); PK4(p1, 0, pa2); PK4(p1, 8, pa3);
            const int vb = vb0 + bufi * SHM;
            pv_one<0>(o[0], vb, pa0, pa1, pa2, pa3); pv_one<1>(o[1], vb, pa0, pa1, pa2, pa3); pv_one<2>(o[2], vb, pa0, pa1, pa2, pa3); pv_one<3>(o[3], vb, pa0, pa1, pa2, pa3);
        }
        __syncthreads();
    }
    const float lam = X.prm[1024];
    float* T = (float*)lds;
    constexpr int NR = SAMPLE ? 64 : 128;
    float fac[16];
    if constexpr (!SAMPLE) {
        if (hi == 0) wsf[32 + r32] = l_reg; asm volatile("s_waitcnt lgkmcnt(0)" ::: "memory");
#pragma unroll
        for (int r = 0; r < 16; ++r) fac[r] = __builtin_amdgcn_rcpf(wsf[32 + crow(r, hi)]) * (c ? -lam : 1.f);
    } else {
        float* TB = (float*)(lds + 40960) + (size_t)(c * 64) * 132;
        float* st = (float*)(lds + 40960 + 67584) + (c * 2 + grp) * 64;
        if (hi == 0) wsf[32 + r32] = l_reg; asm volatile("s_waitcnt lgkmcnt(0)" ::: "memory");
        if (par == 1) {
            if (hi == 0) { st[r32] = m_reg; st[32 + r32] = l_reg; }
#pragma unroll
            for (int r = 0; r < 16; ++r) { const float il = __builtin_amdgcn_rcpf(wsf[32 + crow(r, hi)]);
#pragma unroll
                for (int d = 0; d < 4; ++d) TB[(32 * grp + crow(r, hi)) * 132 + 32 * d + r32] = o[d][r] * il; }
        }
        __syncthreads();
        float wA = 1.f;
        if (par == 0) {
            const float mB = st[r32], lB = st[32 + r32]; const float M_ = fmaxf(m_reg, mB);
            const float fA = l_reg * __builtin_amdgcn_exp2f((m_reg - M_) * C), fB = lB * __builtin_amdgcn_exp2f((mB - M_) * C);
            wA = fA * __builtin_amdgcn_rcpf(fA + fB);
            if (hi == 0) wsf[r32] = wA; asm volatile("s_waitcnt lgkmcnt(0)" ::: "memory");
#pragma unroll
            for (int r = 0; r < 16; ++r) { const float wa = wsf[crow(r, hi)]; const float il = __builtin_amdgcn_rcpf(wsf[32 + crow(r, hi)]);
#pragma unroll
                for (int d = 0; d < 4; ++d) o[d][r] = o[d][r] * il * wa + TB[(32 * grp + crow(r, hi)) * 132 + 32 * d + r32] * (1.f - wa); }
        }
#pragma unroll
        for (int r = 0; r < 16; ++r) fac[r] = c ? -lam : 1.f;
    }
    const bool writer = SAMPLE ? (par == 0) : true;
    if (c == 1 && writer) {
#pragma unroll
        for (int r = 0; r < 16; ++r)
#pragma unroll
            for (int d = 0; d < 4; ++d) T[(32 * grp + crow(r, hi)) * 132 + 32 * d + r32] = o[d][r] * fac[r];
    }
    __syncthreads();
    if (c == 0 && writer) {
#pragma unroll
        for (int r = 0; r < 16; ++r)
#pragma unroll
            for (int d = 0; d < 4; ++d) T[(32 * grp + crow(r, hi)) * 132 + 32 * d + r32] += o[d][r] * fac[r];
    }
    __syncthreads();
    const int row0 = SAMPLE ? (MP_ROWS + b * 64) : (b * 2048 + 128 * qb);
    row_epilogue<NR, false>(T, X.gsub, 0.8f, nullptr, X.YY + (size_t)row0 * 2048 + 1024 + h * 128);
    __syncthreads();
}

__device__ __forceinline__ void hgrn_unit(const Ctx& X, int b, int h, bool sample, char* lds) {
    int tid_ = threadIdx.x; asm volatile("" : "+v"(tid_));
    const int tid = tid_, wid = __builtin_amdgcn_readfirstlane(tid >> 6), lane = tid & 63, r32 = lane & 31, hi = lane >> 5;
    const int g = wid >> 2, d = wid & 3;
    constexpr int QT = 0, KT = 16384, KV = 32768, VV = 49152, ST = 65536, OT = 98304, SEG = 132096, D1 = 136192, D2 = 136704;
    const int row0 = sample ? MP_ROWS + b * 64 : b * 2048, nch = sample ? 1 : 32;
    const int kp = tid & 63, sg = wid;
    const int sr = tid >> 4, sc = (tid & 15) * 8;
    const int et = tid >> 3, ec = (tid & 7) * 16;
    f32x16 S0, S1;
    float* sout = X.out + (sample ? O_SS : O_SP) + ((size_t)(b * 8 + h) * 128) * 128;
    if (sample) { const float* s0 = X.state0 + ((size_t)(b * 8 + h) * 128) * 128;
#pragma unroll
        for (int r = 0; r < 16; ++r) { S0[r] = s0[(size_t)(64 * g + crow(r, hi)) * 128 + 32 * d + r32]; S1[r] = s0[(size_t)(64 * g + 32 + crow(r, hi)) * 128 + 32 * d + r32]; } }
    else {
#pragma unroll
        for (int r = 0; r < 16; ++r) { S0[r] = 0.f; S1[r] = 0.f; } }
    f32x2 lf[8]; unsigned qv[8]; bf16x8 vs0, vs1; u32x4 og0, og1;
#define HG_ISSUE_A(ch_) do { const size_t rb_ = (size_t)(row0 + 64 * (ch_)); \
        _Pragma("unroll") for (int i = 0; i < 8; ++i) { const size_t o_ = (rb_ + 8 * sg + i) * 1024 + h * 128 + 2 * kp; lf[i] = *(const f32x2*)(X.LOGF + o_); qv[i] = *(const unsigned*)(X.QH + o_); } } while (0)
#define HG_ISSUE_B(ch_) do { const size_t rb_ = (size_t)(row0 + 64 * (ch_)); \
        vs0 = *(const bf16x8*)(X.VH + (rb_ + sr) * 1024 + h * 128 + sc); vs1 = *(const bf16x8*)(X.VH + (rb_ + 32 + sr) * 1024 + h * 128 + sc); \
        og0 = *(const u32x4*)(X.OG + (rb_ + et) * 1024 + h * 128 + ec); og1 = *(const u32x4*)(X.OG + (rb_ + et) * 1024 + h * 128 + ec + 8); } while (0)
    HG_ISSUE_A(0); HG_ISSUE_B(0);
    const int vbV = (int)(uintptr_t)(lds + VV) + v_rd_base(lane) + d * 512;
    const int vbK = (int)(uintptr_t)(lds + KV) + v_rd_base(lane) + (2 * g) * 512;
    for (int ch = 0; ch < nch; ++ch) {
        f32x2 pa[8]; pa[0] = lf[0];
#pragma unroll
        for (int i = 1; i < 8; ++i) pa[i] = pa[i - 1] + lf[i];
        *(f32x2*)(lds + SEG + (sg * 128 + 2 * kp) * 4) = pa[7];
        __syncthreads();
        f32x2 off = {0.f, 0.f}, c31 = {0.f, 0.f}, c63 = {0.f, 0.f};
#pragma unroll
        for (int s = 0; s < 8; ++s) { const f32x2 t = *(const f32x2*)(lds + SEG + (s * 128 + 2 * kp) * 4); if (s < sg) off += t; if (s < 4) c31 += t; c63 += t; }
        if (sg == 0) { *(f32x2*)(lds + D1 + 2 * kp * 4) = (f32x2){__builtin_amdgcn_exp2f(c31.x), __builtin_amdgcn_exp2f(c31.y)};
                       *(f32x2*)(lds + D2 + 2 * kp * 4) = (f32x2){__builtin_amdgcn_exp2f(c63.x - c31.x), __builtin_amdgcn_exp2f(c63.y - c31.y)}; }
#pragma unroll
        for (int i = 0; i < 8; ++i) {
            const int t = 8 * sg + i;
            const float bx = off.x + pa[i].x, by = off.y + pa[i].y;
            const float dx = fminf(fmaxf(bx - c31.x, -100.f), 100.f), dy = fminf(fmaxf(by - c31.y, -100.f), 100.f);
            const float qx = bflo(qv[i]) * __builtin_amdgcn_exp2f(dx), qy = bfhi(qv[i]) * __builtin_amdgcn_exp2f(dy);
            const float kx = (1.f - __builtin_amdgcn_exp2f(lf[i].x)) * __builtin_amdgcn_exp2f(-dx), ky = (1.f - __builtin_amdgcn_exp2f(lf[i].y)) * __builtin_amdgcn_exp2f(-dy);
            const unsigned kw = cvtpk(kx, ky);
            *(unsigned*)(lds + QT + KSWZ(t, 4 * kp)) = cvtpk(qx, qy);
            *(unsigned*)(lds + KT + KSWZ(t, 4 * kp)) = kw;
            *(unsigned*)(lds + KV + v_st(t, 2 * kp)) = kw;
        }
        *(bf16x8*)(lds + VV + v_st(sr, sc)) = vs0; *(bf16x8*)(lds + VV + v_st(32 + sr, sc)) = vs1;
        if (ch + 1 < nch) HG_ISSUE_A(ch + 1);
        __syncthreads();
        {
            const float* D1f = (const float*)(lds + D1);
#pragma unroll
            for (int r = 0; r < 16; ++r) { S0[r] *= D1f[64 * g + crow(r, hi)]; S1[r] *= D1f[64 * g + 32 + crow(r, hi)]; }
#pragma unroll
            for (int q4 = 0; q4 < 4; ++q4) {
                u32x2 w0 = {cvtpk(S0[4 * q4], S0[4 * q4 + 1]), cvtpk(S0[4 * q4 + 2], S0[4 * q4 + 3])}, w1 = {cvtpk(S1[4 * q4], S1[4 * q4 + 1]), cvtpk(S1[4 * q4 + 2], S1[4 * q4 + 3])};
                *(u32x2*)(lds + ST + KSWZ(32 * d + r32, (64 * g + 8 * q4 + 4 * hi) * 2)) = w0;
                *(u32x2*)(lds + ST + KSWZ(32 * d + r32, (64 * g + 32 + 8 * q4 + 4 * hi) * 2)) = w1;
            }
        }
        __syncthreads();
        {
            {
                const s16x4 a0l = tr_read<0>(vbK), a0h = tr_read<2048>(vbK), a1l = tr_read<4096>(vbK), a1h = tr_read<4096 + 2048>(vbK);
                const s16x4 a2l = tr_read<8192>(vbK), a2h = tr_read<8192 + 2048>(vbK), a3l = tr_read<12288>(vbK), a3h = tr_read<12288 + 2048>(vbK);
                const s16x4 b0l = tr_read<0>(vbV), b0h = tr_read<2048>(vbV), b1l = tr_read<4096>(vbV), b1h = tr_read<4096 + 2048>(vbV);
                const s16x4 b2l = tr_read<8192>(vbV), b2h = tr_read<8192 + 2048>(vbV), b3l = tr_read<12288>(vbV), b3h = tr_read<12288 + 2048>(vbV);
                asm volatile("s_waitcnt lgkmcnt(0)" ::: "memory"); SBAR();
                S0 = __builtin_amdgcn_mfma_f32_32x32x16_bf16(PKF(a0l, a0h), PKF(b0l, b0h), S0, 0, 0, 0);
                S0 = __builtin_amdgcn_mfma_f32_32x32x16_bf16(PKF(a1l, a1h), PKF(b1l, b1h), S0, 0, 0, 0);
                S0 = __builtin_amdgcn_mfma_f32_32x32x16_bf16(PKF(a2l, a2h), PKF(b2l, b2h), S0, 0, 0, 0);
                S0 = __builtin_amdgcn_mfma_f32_32x32x16_bf16(PKF(a3l, a3h), PKF(b3l, b3h), S0, 0, 0, 0);
                const s16x4 c0l = tr_read<512>(vbK), c0h = tr_read<512 + 2048>(vbK), c1l = tr_read<512 + 4096>(vbK), c1h = tr_read<512 + 4096 + 2048>(vbK);
                const s16x4 c2l = tr_read<512 + 8192>(vbK), c2h = tr_read<512 + 8192 + 2048>(vbK), c3l = tr_read<512 + 12288>(vbK), c3h = tr_read<512 + 12288 + 2048>(vbK);
                asm volatile("s_waitcnt lgkmcnt(0)" ::: "memory"); SBAR();
                S1 = __builtin_amdgcn_mfma_f32_32x32x16_bf16(PKF(c0l, c0h), PKF(b0l, b0h), S1, 0, 0, 0);
                S1 = __builtin_amdgcn_mfma_f32_32x32x16_bf16(PKF(c1l, c1h), PKF(b1l, b1h), S1, 0, 0, 0);
                S1 = __builtin_amdgcn_mfma_f32_32x32x16_bf16(PKF(c2l, c2h), PKF(b2l, b2h), S1, 0, 0, 0);
                S1 = __builtin_amdgcn_mfma_f32_32x32x16_bf16(PKF(c3l, c3h), PKF(b3l, b3h), S1, 0, 0, 0);
                const float* D2f = (const float*)(lds + D2);
#pragma unroll
                for (int r = 0; r < 16; ++r) { S0[r] *= D2f[64 * g + crow(r, hi)]; S1[r] *= D2f[64 * g + 32 + crow(r, hi)]; }
            }
            asm volatile("" ::: "memory");
            f32x16 p0, p1;
#pragma unroll
            for (int r = 0; r < 16; ++r) { p0[r] = 0.f; p1[r] = 0.f; }
#pragma unroll
            for (int ks = 0; ks < 8; ++ks) { const bf16x8 qf = *(const bf16x8*)(lds + QT + KSWZ(32 * g + r32, (16 * ks + 8 * hi) * 2));
                const bf16x8 a0 = *(const bf16x8*)(lds + KT + KSWZ(r32, (16 * ks + 8 * hi) * 2));
                p0 = __builtin_amdgcn_mfma_f32_32x32x16_bf16(a0, qf, p0, 0, 0, 0);
                if (g == 1) { const bf16x8 a1 = *(const bf16x8*)(lds + KT + KSWZ(32 + r32, (16 * ks + 8 * hi) * 2));
                    p1 = __builtin_amdgcn_mfma_f32_32x32x16_bf16(a1, qf, p1, 0, 0, 0); } }
            if (g == 0) {
#pragma unroll
                for (int r = 0; r < 16; ++r) p0[r] = (crow(r, hi) <= r32) ? p0[r] : 0.f;
            } else {
#pragma unroll
                for (int r = 0; r < 16; ++r) p1[r] = (crow(r, hi) <= r32) ? p1[r] : 0.f;
            }
            bf16x8 pa0, pa1, pa2, pa3;
            PK4(p0, 0, pa0); PK4(p0, 8, pa1); PK4(p1, 0, pa2); PK4(p1, 8, pa3);
            f32x16 o;
#pragma unroll
            for (int r = 0; r < 16; ++r) o[r] = 0.f;
            {
                const s16x4 l0 = tr_read<0>(vbV), h0 = tr_read<2048>(vbV), l1 = tr_read<4096>(vbV), h1 = tr_read<4096 + 2048>(vbV);
                const s16x4 l2 = tr_read<8192>(vbV), h2 = tr_read<8192 + 2048>(vbV), l3 = tr_read<12288>(vbV), h3 = tr_read<12288 + 2048>(vbV);
                asm volatile("s_waitcnt lgkmcnt(0)" ::: "memory"); SBAR();
                o = __builtin_amdgcn_mfma_f32_32x32x16_bf16(pa0, PKF(l0, h0), o, 0, 0, 0);
                o = __builtin_amdgcn_mfma_f32_32x32x16_bf16(pa1, PKF(l1, h1), o, 0, 0, 0);
                if (g == 1) { o = __builtin_amdgcn_mfma_f32_32x32x16_bf16(pa2, PKF(l2, h2), o, 0, 0, 0);
                              o = __builtin_amdgcn_mfma_f32_32x32x16_bf16(pa3, PKF(l3, h3), o, 0, 0, 0); }
            }
#pragma unroll
            for (int ks = 0; ks < 8; ++ks) { const bf16x8 bs = *(const bf16x8*)(lds + ST + KSWZ(32 * d + r32, (16 * ks + 8 * hi) * 2));
                const bf16x8 qf = *(const bf16x8*)(lds + QT + KSWZ(32 * g + r32, (16 * ks + 8 * hi) * 2));
                o = __builtin_amdgcn_mfma_f32_32x32x16_bf16(qf, bs, o, 0, 0, 0); }
            float* OTf = (float*)(lds + OT);
#pragma unroll
            for (int r = 0; r < 16; ++r) OTf[(32 * g + crow(r, hi)) * 132 + 32 * d + r32] = o[r];
        }
        __syncthreads();
        {
            const float* T = (const float*)(lds + OT) + et * 132 + ec;
            float v[16]; float ss = 0.f;
#pragma unroll
            for (int i = 0; i < 16; i += 4) { const f32x4 x = *(const f32x4*)(T + i); v[i] = x[0]; v[i + 1] = x[1]; v[i + 2] = x[2]; v[i + 3] = x[3]; ss += x[0] * x[0] + x[1] * x[1] + x[2] * x[2] + x[3] * x[3]; }
            ss += __shfl_xor(ss, 1); ss += __shfl_xor(ss, 2); ss += __shfl_xor(ss, 4);
            const float rs = __builtin_amdgcn_rsqf(ss * (1.f / 128.f) + LN_EPS);
            const f32x4 g0 = *(const f32x4*)(X.gnorm + ec), g1 = *(const f32x4*)(X.gnorm + ec + 4), g2 = *(const f32x4*)(X.gnorm + ec + 8), g3 = *(const f32x4*)(X.gnorm + ec + 12);
            u32x4 w0, w1;
            w0.x = cvtpk(v[0] * rs * g0[0] * bflo(og0.x), v[1] * rs * g0[1] * bfhi(og0.x)); w0.y = cvtpk(v[2] * rs * g0[2] * bflo(og0.y), v[3] * rs * g0[3] * bfhi(og0.y));
            w0.z = cvtpk(v[4] * rs * g1[0] * bflo(og0.z), v[5] * rs * g1[1] * bfhi(og0.z)); w0.w = cvtpk(v[6] * rs * g1[2] * bflo(og0.w), v[7] * rs * g1[3] * bfhi(og0.w));
            w1.x = cvtpk(v[8] * rs * g2[0] * bflo(og1.x), v[9] * rs * g2[1] * bfhi(og1.x)); w1.y = cvtpk(v[10] * rs * g2[2] * bflo(og1.y), v[11] * rs * g2[3] * bfhi(og1.y));
            w1.z = cvtpk(v[12] * rs * g3[0] * bflo(og1.z), v[13] * rs * g3[1] * bfhi(og1.z)); w1.w = cvtpk(v[14] * rs * g3[2] * bflo(og1.w), v[15] * rs * g3[3] * bfhi(og1.w));
            bf16_t* yp = X.YY + (size_t)(row0 + 64 * ch + et) * 2048 + h * 128 + ec;
            *(u32x4*)yp = w0; *(u32x4*)(yp + 8) = w1;
        }
        if (ch + 1 < nch) HG_ISSUE_B(ch + 1);
    }
#undef HG_ISSUE_A
#undef HG_ISSUE_B
#pragma unroll
    for (int r = 0; r < 16; ++r) { sout[(size_t)(64 * g + crow(r, hi)) * 128 + 32 * d + r32] = S0[r]; sout[(size_t)(64 * g + 32 + crow(r, hi)) * 128 + 32 * d + r32] = S1[r]; }
    __syncthreads();
}
}
namespace cg = cooperative_groups;
#define GAS __attribute__((address_space(1)))
#define LAS __attribute__((address_space(3)))
typedef unsigned short bf16;
typedef unsigned v4u __attribute__((ext_vector_type(4)));
typedef unsigned v2u __attribute__((ext_vector_type(2)));
typedef float f32x4 __attribute__((ext_vector_type(4)));
#define LDS_WAIT() asm volatile("s_waitcnt lgkmcnt(0)" ::: "memory")
__device__ __forceinline__ unsigned f2bf(float f) { unsigned u = __builtin_bit_cast(unsigned, f); return (u + 0x7fffu + ((u >> 16) & 1u)) >> 16; }
__device__ __forceinline__ unsigned pk2(float lo, float hi) { return f2bf(lo) | (f2bf(hi) << 16); }

#define XB_TMO      128
#define XB_XCNT(j)  (256  + 64 * (j))
#define XB_XSUB(j)  (1280 + 64 * (j))
#define XB_XGEN(j)  (2304 + 64 * (j))
#define XB_TOP      3328
#define XB_TOPGEN   3392
#define XCD_BAR_WORDS 3456
#define XB_SPIN_CAP (1u << 18)
__device__ __forceinline__ unsigned xb_ld(unsigned* p)              { return __hip_atomic_load(p, __ATOMIC_RELAXED, __HIP_MEMORY_SCOPE_AGENT); }
__device__ __forceinline__ unsigned xb_add(unsigned* p, unsigned v) { return __hip_atomic_fetch_add(p, v, __ATOMIC_RELAXED, __HIP_MEMORY_SCOPE_AGENT); }
__device__ __forceinline__ unsigned xb_xcc_id() { return (unsigned)__builtin_amdgcn_s_getreg((3 << 11) | 20) & 0xFu; }
#define XB_SPIN(cond, bar) do { unsigned _sp = 0; while (cond) { __builtin_amdgcn_s_sleep(1); \
    if ((++_sp & 255u) == 0u) { if (xb_ld(&(bar)[XB_TMO])) break; if (_sp > XB_SPIN_CAP) { atomicAdd(&(bar)[XB_TMO], 1u); break; } } } } while (0)
struct XcdBarrier { unsigned* bar; unsigned x; volatile LAS unsigned* st; };
__device__ __forceinline__ XcdBarrier xcd_barrier_post(unsigned* bar, volatile LAS unsigned* st) {
    XcdBarrier b; b.bar = bar; b.x = xb_xcc_id(); b.st = st;
    if (threadIdx.x == 0) (void)xb_add(&bar[XB_XCNT(b.x)], 1u);
    return b;
}
__device__ __forceinline__ void xcd_barrier_complete(unsigned* bar, unsigned x, unsigned& nloc, unsigned& nx) {
    const unsigned G = gridDim.x * gridDim.y * gridDim.z;
    unsigned sum, cnt, mine, sp = 0u;
    for (;;) {
        sum = 0u; cnt = 0u; mine = 0u;
#pragma unroll
        for (unsigned j = 0; j < 16; ++j) { const unsigned c = xb_ld(&bar[XB_XCNT(j)]); sum += c; cnt += (c > 0u) ? 1u : 0u; mine = (j == x) ? c : mine; }
        if (sum == G) break;
        __builtin_amdgcn_s_sleep(1);
        if ((++sp & 255u) == 0u) { if (xb_ld(&bar[XB_TMO])) break; if (sp > XB_SPIN_CAP) { atomicAdd(&bar[XB_TMO], 1u); break; } }
    }
    nloc = mine > 0u ? mine : 1u; nx = cnt > 0u ? cnt : 1u;
}
__device__ __forceinline__ void xcd_barrier(const XcdBarrier& b) {
    asm volatile("s_waitcnt vmcnt(0)" ::: "memory");
    __syncthreads();
    if (threadIdx.x == 0) {
        unsigned* bar = b.bar;
        __builtin_amdgcn_s_waitcnt(0);
        unsigned nloc = b.st[0], nx = b.st[1];
        if (nloc == 0u) { xcd_barrier_complete(bar, b.x, nloc, nx); b.st[0] = nloc; b.st[1] = nx; }
        const unsigned old = xb_add(&bar[XB_XSUB(b.x)], 1u);
        const unsigned gen = old / nloc;
        if (old + 1u == (gen + 1u) * nloc) {
            __builtin_amdgcn_fence(__ATOMIC_RELEASE, "agent");
            asm volatile("s_waitcnt vmcnt(0)" ::: "memory");
            const unsigned og = xb_add(&bar[XB_TOP], 1u);
            const unsigned tg = og / nx;
            if (og + 1u == (tg + 1u) * nx) xb_add(&bar[XB_TOPGEN], 1u);
            else XB_SPIN(xb_ld(&bar[XB_TOPGEN]) == tg, bar);
            __builtin_amdgcn_fence(__ATOMIC_ACQUIRE, "agent");
            xb_add(&bar[XB_XGEN(b.x)], 1u);
            asm volatile("s_waitcnt vmcnt(0)" ::: "memory");
        } else {
            XB_SPIN(xb_ld(&bar[XB_XGEN(b.x)]) == gen, bar);
            __builtin_amdgcn_fence(__ATOMIC_ACQUIRE, "agent");
            asm volatile("s_waitcnt vmcnt(0)" ::: "memory");
        }
    }
    __syncthreads();
}

constexpr int M = 17408, MP = 16384, DMODEL = 1024, INW = 9216, FF2 = 5632, FF = 2816;
constexpr float LN_EPS_F = 1e-5f;
constexpr size_t MiB = 1u << 20;
constexpr size_t WS_CTL = 0, CTL_ZERO_BYTES = 1 * MiB, WS_PRM = 1 * MiB;
constexpr size_t WS_WIN = 2 * MiB, WS_WB = 20 * MiB, WS_WOUT = 24 * MiB, WS_WUP = 26 * MiB, WS_WDN = 37 * MiB;
constexpr size_t WS_XB = 44 * MiB, WS_QH = 78 * MiB, WS_LOGF = 112 * MiB, WS_VH = 180 * MiB, WS_OG = 214 * MiB, WS_DQ = 248 * MiB, WS_DK = 282 * MiB, WS_DV = 316 * MiB,
                 WS_GH = 350 * MiB, WS_GD = 384 * MiB, WS_YY = 418 * MiB;
constexpr size_t WS_MB = 44 * MiB, WS_PRE1 = 146 * MiB, WS_H = 214 * MiB, WS_HB = 282 * MiB, WS_UP = 316 * MiB, WS_ACT = 44 * MiB, WS_PRE2 = 146 * MiB, WS_END = 504 * MiB;
constexpr int CW_Q0 = 1024, CW_BAR = 4096;
constexpr int LDS_BYTES = 163840, MISC_OFF = 163840 - 256;

struct Args { const float* in[25]; float* out; unsigned char* ws; int ph_lo, ph_hi; };

__device__ __forceinline__ void transpose_item(const float* W, int ldw, bf16* WT, int ldt, int koff, int k0, int n0, LAS float* scr, int lane) {
#pragma unroll 8
    for (int i = 0; i < 32; ++i) { const int kk = 2 * i + (lane >> 5); scr[kk * 33 + (lane & 31)] = W[(size_t)(k0 + kk) * ldw + n0 + (lane & 31)]; }
    LDS_WAIT(); asm volatile("" ::: "memory");
    const int c = lane & 7;
#pragma unroll
    for (int j = 0; j < 4; ++j) { const int n = (lane >> 3) + 8 * j; const LAS float* s = scr + (8 * c) * 33 + n;
        v4u o; o.x = pk2(s[0 * 33], s[1 * 33]); o.y = pk2(s[2 * 33], s[3 * 33]); o.z = pk2(s[4 * 33], s[5 * 33]); o.w = pk2(s[6 * 33], s[7 * 33]);
        *(GAS v4u*)(WT + (size_t)(n0 + n) * ldt + koff + k0 + 8 * c) = o; }
    LDS_WAIT(); asm volatile("" ::: "memory");
}
__device__ __forceinline__ float wave_sum(float v) {
#pragma unroll
    for (int o = 1; o < 64; o <<= 1) v += __shfl_xor(v, o);
    return v;
}

__global__ void __launch_bounds__(512, 2) fused_fwd(Args args) {
    extern __shared__ __attribute__((aligned(16))) unsigned char lds[];
    LAS unsigned char* ldsl = (LAS unsigned char*)lds;
    volatile LAS unsigned* MISC = (volatile LAS unsigned*)(ldsl + MISC_OFF);
    const int tid = threadIdx.x, lane = tid & 63, wave = __builtin_amdgcn_readfirstlane(tid >> 6);
    const int G = gridDim.x;
    const Args& A = *(const Args*)__builtin_amdgcn_kernarg_segment_ptr();
#define args A
    unsigned char* ws = A.ws; float* out = A.out;
    unsigned* ctl = (unsigned*)(ws + WS_CTL);
    for (int u = tid; u < 64; u += 512) MISC[u] = 0u;
    __syncthreads();
    const bool one_launch = (args.ph_hi - args.ph_lo) > 1;
    XcdBarrier bar; bar.bar = ctl + CW_BAR; bar.x = 0; bar.st = nullptr;
    if (one_launch) bar = xcd_barrier_post(ctl + CW_BAR, MISC + 8);
    const int lo = args.ph_lo, hi = args.ph_hi;
#ifndef PH_MASK
#define PH_MASK 0x3ff
#endif
#define IN(k) ((((PH_MASK) >> (k)) & 1) && lo <= (k) && (k) < hi)
#define GRID_BAR(k) do { if (IN(k) && IN((k) + 1)) xcd_barrier(bar); } while (0)
#define WIN_T ((bf16*)(ws + WS_WIN))
#define WB_T ((bf16*)(ws + WS_WB))
#define WOUT_T ((bf16*)(ws + WS_WOUT))
#define WUP_T ((bf16*)(ws + WS_WUP))
#define WDN_T ((bf16*)(ws + WS_WDN))
#define XB ((bf16*)(ws + WS_XB))
#define QH ((bf16*)(ws + WS_QH))
#define LOGF ((float*)(ws + WS_LOGF))
#define VH ((bf16*)(ws + WS_VH))
#define OG ((bf16*)(ws + WS_OG))
#define DQ ((bf16*)(ws + WS_DQ))
#define DK ((bf16*)(ws + WS_DK))
#define DV ((bf16*)(ws + WS_DV))
#define GH ((bf16*)(ws + WS_GH))
#define GD ((bf16*)(ws + WS_GD))
#define YY ((bf16*)(ws + WS_YY))
#define MB ((bf16*)(ws + WS_MB))
#define PRE1 ((float*)(ws + WS_PRE1))
#define H ((float*)(ws + WS_H))
#define HB ((bf16*)(ws + WS_HB))
#define UP ((bf16*)(ws + WS_UP))
#define ACT ((bf16*)(ws + WS_ACT))
#define PRE2 ((float*)(ws + WS_PRE2))
#define PRM ((float*)(ws + WS_PRM))
    const int gw = blockIdx.x * 8 + wave, NGW = G * 8;

    if (IN(0)) {
        LAS float* scr = (LAS float*)(ldsl + wave * 16384);
        constexpr int I_IN = 16 * 288, I_B = 16 * 32, I_UP = 16 * 176, I_DN = 44 * 32;
        constexpr int NITEMS = I_IN + 3 * I_B + I_UP + I_DN;
        for (int it = gw; it < NITEMS; it += NGW) {
            int r = it;
            if (r < I_IN) { transpose_item(args.in[6], INW, WIN_T, 1024, 0, 64 * (r / 288), 32 * (r % 288), scr, lane); continue; } r -= I_IN;
            if (r < I_B) { transpose_item(args.in[14], 1024, WB_T, 2048, 0, 64 * (r / 32), 32 * (r % 32), scr, lane); continue; } r -= I_B;
            if (r < I_B) { transpose_item(args.in[15], 1024, WB_T, 2048, 1024, 64 * (r / 32), 32 * (r % 32), scr, lane); continue; } r -= I_B;
            if (r < I_B) { transpose_item(args.in[16], 1024, WOUT_T, 1024, 0, 64 * (r / 32), 32 * (r % 32), scr, lane); continue; } r -= I_B;
            if (r < I_UP) { transpose_item(args.in[19], FF2, WUP_T, 1024, 0, 64 * (r / 176), 32 * (r % 176), scr, lane); continue; } r -= I_UP;
            transpose_item(args.in[22], 1024, WDN_T, FF, 0, 64 * (r / 32), 32 * (r % 32), scr, lane);
        }
        for (int m = gw; m < M; m += NGW) {
            const float* xr = (m < MP) ? args.in[0] + (size_t)m * 1024 : args.in[1] + (size_t)(m - MP) * 1024;
            const GAS f32x4* x4 = (const GAS f32x4*)xr + lane;
            GAS v2u* o8 = (GAS v2u*)(XB + (size_t)m * 1024) + lane;
#pragma unroll
            for (int j = 0; j < 4; ++j) { const f32x4 v = x4[64 * j]; v2u w; w.x = pk2(v.x, v.y); w.y = pk2(v.z, v.w); o8[64 * j] = w; }
        }
        if (blockIdx.x == 0) {
            for (int t = tid; t < 1024; t += 512) { const float a = args.in[7][t], b = args.in[7][1024 + t]; const float mx = fmaxf(a, b); const float ea = expf(a - mx), eb = expf(b - mx); PRM[t] = ea / (ea + eb); }
            if (tid == 0) { float s1 = 0.f, s2 = 0.f; for (int i = 0; i < 64; ++i) { s1 += args.in[9][i] * args.in[10][i]; s2 += args.in[11][i] * args.in[12][i]; } PRM[1024] = expf(s1) - expf(s2) + 0.2f; }
        }
        if (IN(1)) { cg::this_grid().sync(); }
    }

    if (IN(1)) {
        pg8::Gemm g{XB, WIN_T, M, INW, 1024}; pg8::StaticOrder S; S.init(M, INW, G, (int)blockIdx.x);
        pg8::EpiIn E{QH, VH, OG, DQ, DK, DV, GH, GD, LOGF, PRM, out + mix::O_KP, out + mix::O_KS, out + mix::O_VP, out + mix::O_VS};
        pg8::gemm_phase<pg8::EpiIn, pg8::StaticOrder, true, true>(ldsl, g, S, E);
        GRID_BAR(1);
    }

    if (IN(2)) {
        mix::Ctx X{QH, VH, OG, DQ, DK, DV, LOGF, YY, args.in[2], args.in[3], args.in[4], args.in[8], args.in[13], PRM, out};
        const unsigned q0 = xb_xcc_id() & 7u;
        volatile LAS unsigned* bc = MISC + 16;
        for (int k = 0; k < 8; ++k) {
            const int q = (int)((q0 + k) & 7u);
            for (;;) {
                if (tid == 0) bc[0] = __hip_atomic_fetch_add(ctl + CW_Q0 + 64 * q, 1u, __ATOMIC_RELAXED, __HIP_MEMORY_SCOPE_AGENT);
                __syncthreads();
                const int u = (int)bc[0];
                __syncthreads();
                if (u >= 168) break;
#ifndef UNIT_MASK
#define UNIT_MASK 7
#endif
                if (u < 8) { if (UNIT_MASK & 1) mix::hgrn_unit(X, u, q, false, (char*)lds); }
                else if (u < 24) { if (UNIT_MASK & 2) mix::attn_unit<true>(X, u - 8, q, 0, (char*)lds); }
                else if (u < 152) { const int j = u - 24; if (UNIT_MASK & 4) mix::attn_unit<false>(X, j & 7, q, 15 - (j >> 3), (char*)lds); }
                else { if (UNIT_MASK & 1) mix::hgrn_unit(X, u - 152, q, true, (char*)lds); }
            }
        }
        GRID_BAR(2);
    }

    if (IN(3)) {
        pg8::Gemm g{YY, WB_T, M, 1024, 2048}; pg8::StaticOrder S; S.init(M, 1024, G, (int)blockIdx.x);
        pg8::EpiBr E{GH, GD, MB};
        pg8::gemm_phase<pg8::EpiBr, pg8::StaticOrder, true, true>(ldsl, g, S, E);
        GRID_BAR(3);
    }
    if (IN(4)) {
        pg8::Gemm g{MB, WOUT_T, M, 1024, 1024}; pg8::StaticOrder S; S.init(M, 1024, G, (int)blockIdx.x);
        pg8::EpiRes E{args.in[0], args.in[1], PRE1};
        pg8::gemm_phase<pg8::EpiRes, pg8::StaticOrder, true, true>(ldsl, g, S, E);
        GRID_BAR(4);
    }
    if (IN(5)) {
        const float* gg = args.in[17]; const float* bb = args.in[18];
        for (int m = gw; m < M; m += NGW) {
            const GAS f32x4* xr = (const GAS f32x4*)(PRE1 + (size_t)m * 1024) + lane;
            f32x4 v[4]; float s = 0.f;
#pragma unroll
            for (int j = 0; j < 4; ++j) { v[j] = xr[64 * j]; s += (v[j].x + v[j].y) + (v[j].z + v[j].w); }
            const float mean = wave_sum(s) * (1.f / 1024.f); float s2 = 0.f;
#pragma unroll
            for (int j = 0; j < 4; ++j) { v[j] = v[j] - mean; s2 += (v[j].x * v[j].x + v[j].y * v[j].y) + (v[j].z * v[j].z + v[j].w * v[j].w); }
            const float rstd = 1.f / sqrtf(wave_sum(s2) * (1.f / 1024.f) + LN_EPS_F);
            GAS f32x4* ho = (GAS f32x4*)(H + (size_t)m * 1024) + lane; GAS v2u* hb = (GAS v2u*)(HB + (size_t)m * 1024) + lane;
#pragma unroll
            for (int j = 0; j < 4; ++j) { const f32x4 g4 = *((const f32x4*)gg + lane + 64 * j), b4 = *((const f32x4*)bb + lane + 64 * j);
                const f32x4 y = v[j] * rstd * g4 + b4; ho[64 * j] = y; v2u w; w.x = pk2(y.x, y.y); w.y = pk2(y.z, y.w); hb[64 * j] = w; }
        }
        GRID_BAR(5);
    }
    if (IN(6)) {
        pg8::Gemm g{HB, WUP_T, M, FF2, 1024}; pg8::StaticOrder S; S.init(M, FF2, G, (int)blockIdx.x);
        pg8::EpiUp E{UP, out + mix::O_CP, out + mix::O_CS};
        pg8::gemm_phase<pg8::EpiUp, pg8::StaticOrder, true, true>(ldsl, g, S, E);
        GRID_BAR(6);
    }
    if (IN(7)) {
        const float* cw = args.in[20]; const float* cb = args.in[21]; const float* buf0 = args.in[5];
        constexpr int NCG = FF / 8, NRB = M / 16;
        for (int it = blockIdx.x * 512 + tid; it < NCG * NRB; it += G * 512) {
            const int cgp = it % NCG, rb = it / NCG, r0 = rb * 16, j0 = cgp * 8;
            float wv[3][8], wg[3][8], bv[8], bg[8];
#pragma unroll
            for (int e = 0; e < 8; ++e) { bv[e] = cb[j0 + e]; bg[e] = cb[FF + j0 + e];
#pragma unroll
                for (int k = 0; k < 3; ++k) { wv[k][e] = cw[k * FF2 + j0 + e]; wg[k][e] = cw[k * FF2 + FF + j0 + e]; } }
            float v0[8], v1[8], g0[8], g1[8];
            const bool seq_start = (r0 < MP) ? ((r0 & 2047) == 0) : (((r0 - MP) & 63) == 0);
            if (!seq_start) {
                const v4u a0 = *(const v4u*)(UP + (size_t)(r0 - 2) * FF2 + j0), a1 = *(const v4u*)(UP + (size_t)(r0 - 1) * FF2 + j0);
                const v4u c0 = *(const v4u*)(UP + (size_t)(r0 - 2) * FF2 + FF + j0), c1 = *(const v4u*)(UP + (size_t)(r0 - 1) * FF2 + FF + j0);
#pragma unroll
                for (int e = 0; e < 4; ++e) { v0[2 * e] = __uint_as_float(a0[e] << 16); v0[2 * e + 1] = __uint_as_float(a0[e] & 0xffff0000u); v1[2 * e] = __uint_as_float(a1[e] << 16); v1[2 * e + 1] = __uint_as_float(a1[e] & 0xffff0000u);
                    g0[2 * e] = __uint_as_float(c0[e] << 16); g0[2 * e + 1] = __uint_as_float(c0[e] & 0xffff0000u); g1[2 * e] = __uint_as_float(c1[e] << 16); g1[2 * e + 1] = __uint_as_float(c1[e] & 0xffff0000u); }
            } else if (r0 >= MP) {
                const int b = (r0 - MP) >> 6;
#pragma unroll
                for (int e = 0; e < 8; ++e) { v0[e] = buf0[((size_t)b * 2 + 0) * FF2 + j0 + e]; v1[e] = buf0[((size_t)b * 2 + 1) * FF2 + j0 + e];
                    g0[e] = buf0[((size_t)b * 2 + 0) * FF2 + FF + j0 + e]; g1[e] = buf0[((size_t)b * 2 + 1) * FF2 + FF + j0 + e]; }
            } else {
#pragma unroll
                for (int e = 0; e < 8; ++e) { v0[e] = 0.f; v1[e] = 0.f; g0[e] = 0.f; g1[e] = 0.f; }
            }
#pragma unroll 4
            for (int i = 0; i < 16; ++i) {
                const v4u a2 = *(const v4u*)(UP + (size_t)(r0 + i) * FF2 + j0), c2 = *(const v4u*)(UP + (size_t)(r0 + i) * FF2 + FF + j0);
                float v2[8], g2[8], o[8];
#pragma unroll
                for (int e = 0; e < 4; ++e) { v2[2 * e] = __uint_as_float(a2[e] << 16); v2[2 * e + 1] = __uint_as_float(a2[e] & 0xffff0000u); g2[2 * e] = __uint_as_float(c2[e] << 16); g2[2 * e + 1] = __uint_as_float(c2[e] & 0xffff0000u); }
#pragma unroll
                for (int e = 0; e < 8; ++e) { const float val = bv[e] + wv[0][e] * v0[e] + wv[1][e] * v1[e] + wv[2][e] * v2[e]; const float gat = bg[e] + wg[0][e] * g0[e] + wg[1][e] * g1[e] + wg[2][e] * g2[e];
                    o[e] = gat * pg8::sigm(gat) * val; v0[e] = v1[e]; v1[e] = v2[e]; g0[e] = g1[e]; g1[e] = g2[e]; }
                v4u w; w.x = pk2(o[0], o[1]); w.y = pk2(o[2], o[3]); w.z = pk2(o[4], o[5]); w.w = pk2(o[6], o[7]);
                *(v4u*)(ACT + (size_t)(r0 + i) * FF + j0) = w;
            }
        }
        GRID_BAR(7);
    }
    if (IN(8)) {
        pg8::Gemm g{ACT, WDN_T, M, 1024, FF}; pg8::StaticOrder S; S.init(M, 1024, G, (int)blockIdx.x);
        pg8::EpiRes E{H, H + (size_t)MP * 1024, PRE2};
        pg8::gemm_phase<pg8::EpiRes, pg8::StaticOrder, true, true>(ldsl, g, S, E);
        GRID_BAR(8);
    }
    if (IN(9)) {
        const float* gg = args.in[23]; const float* bb = args.in[24];
        for (int m = gw; m < M; m += NGW) {
            const GAS f32x4* xr = (const GAS f32x4*)(PRE2 + (size_t)m * 1024) + lane;
            f32x4 v[4]; float s = 0.f;
#pragma unroll
            for (int j = 0; j < 4; ++j) { v[j] = xr[64 * j]; s += (v[j].x + v[j].y) + (v[j].z + v[j].w); }
            const float mean = wave_sum(s) * (1.f / 1024.f); float s2 = 0.f;
#pragma unroll
            for (int j = 0; j < 4; ++j) { v[j] = v[j] - mean; s2 += (v[j].x * v[j].x + v[j].y * v[j].y) + (v[j].z * v[j].z + v[j].w * v[j].w); }
            const float rstd = 1.f / sqrtf(wave_sum(s2) * (1.f / 1024.f) + LN_EPS_F);
            GAS f32x4* yo = (GAS f32x4*)(out + (size_t)m * 1024) + lane;
#pragma unroll
            for (int j = 0; j < 4; ++j) { const f32x4 g4 = *((const f32x4*)gg + lane + 64 * j), b4 = *((const f32x4*)bb + lane + 64 * j); yo[64 * j] = v[j] * rstd * g4 + b4; }
        }
    }
#undef IN
#undef GRID_BAR
#undef args
}
#undef WIN_T
#undef WB_T
#undef WOUT_T
#undef WUP_T
#undef WDN_T
#undef XB
#undef QH
#undef LOGF
#undef VH
#undef OG
#undef DQ
#undef DK
#undef DV
#undef GH
#undef GD
#undef YY
#undef MB
#undef PRE1
#undef H
#undef HB
#undef UP
#undef ACT
#undef PRE2
#undef PRM


constexpr int N_PHASES = 10;
static int fast_grid() {
    static int grid = 0;
    if (grid == 0) {
        int dev = 0, cus = 0, per_cu = 0;
        (void)hipGetDevice(&dev);
        (void)hipDeviceGetAttribute(&cus, hipDeviceAttributeMultiprocessorCount, dev);
        (void)hipFuncSetAttribute((const void*)fused_fwd, hipFuncAttributeMaxDynamicSharedMemorySize, LDS_BYTES);
        if (hipOccupancyMaxActiveBlocksPerMultiprocessor(&per_cu, (const void*)fused_fwd, 512, LDS_BYTES) != hipSuccess || per_cu < 1) { fprintf(stderr, "occupancy query: %d blocks per CU\n", per_cu); per_cu = 1; }
        (void)hipGetLastError();
        grid = cus;
        fprintf(stderr, "fused_fwd: grid %d (occupancy query %d per CU)\n", grid, per_cu);
    }
    return grid;
}
static void fast_launch(void* const* d_in, float* out, unsigned char* ws, hipStream_t stream, bool one_launch) {
    const int grid = fast_grid();
    (void)hipMemsetAsync(ws + WS_CTL, 0, CTL_ZERO_BYTES, stream);
    Args a{};
    for (int i = 0; i < 25; ++i) a.in[i] = (const float*)d_in[i];
    a.out = out; a.ws = ws;
    if (one_launch) {
        a.ph_lo = 0; a.ph_hi = N_PHASES;
        void* kargs[] = {&a};
        const hipError_t e = hipLaunchCooperativeKernel((const void*)fused_fwd, dim3(grid), dim3(512), kargs, LDS_BYTES, stream);
        if (e != hipSuccess) fprintf(stderr, "cooperative launch failed: %s (grid %d)\n", hipGetErrorString(e), grid);
    } else {
        for (int p = 0; p < N_PHASES; ++p) { a.ph_lo = p; a.ph_hi = p + 1; hipLaunchKernelGGL(fused_fwd, dim3(grid), dim3(512), LDS_BYTES, stream, a); }
    }
}
extern "C" void kernel_launch(void* const* d_in, const int* in_sizes, int n_in, void* d_out, int out_size, void* d_ws, size_t ws_size, hipStream_t stream) {
    fast_launch(d_in, (float*)d_out, (unsigned char*)d_ws, stream, ONE_LAUNCH);
}
```
